# Optimizing an MI355X kernel written in HIP

```python
import math
import jax, jax.numpy as jnp
from jax import lax
import numpy as np

D_MODEL = 1024
BATCH = 4
SEQ = 8192
DEPTH = 1

CHUNK = 64
D_SSM = D_MODEL // 2
SSM_GROUP = 16
N_GROUPS = D_SSM // SSM_GROUP
STATE = 64
N_HEADS = 8
HEAD_DIM = 64
D_ATTN = N_HEADS * HEAD_DIM
D_IN = D_SSM + 3 * D_ATTN
D_FF = 4 * D_MODEL
Q_BLOCK = 128
EPS = 1e-6
DT_MIN = 1e-3
DT_MAX = 1e-1

kernel_name = "hybrid_s5_stickbreaking_gated_block"


def rmsnorm(x, g):
    xf = x.astype(jnp.float32)
    y = xf * lax.rsqrt(jnp.mean(xf * xf, axis=-1, keepdims=True) + EPS)
    return (y * g.astype(jnp.float32)).astype(x.dtype)


def s5_branch(u, A_re, A_im, log_dt, B_re, B_im, C_re, C_im, D_skip, w_glu, b_glu):
    f32 = jnp.float32
    bsz, seq, _ = u.shape
    uf = u.astype(f32)
    ug = uf.reshape(bsz, seq, N_GROUPS, SSM_GROUP)
    lam = lax.complex(A_re.astype(f32), A_im.astype(f32))
    dt = jnp.exp(log_dt.astype(f32))[:, None]
    a_bar = jnp.exp(lam * dt)
    b_bar = ((a_bar - 1.0) / lam)[..., None] * lax.complex(B_re.astype(f32), B_im.astype(f32))
    bu = lax.complex(jnp.einsum('bsgc,gpc->bsgp', ug, b_bar.real),
                     jnp.einsum('bsgc,gpc->bsgp', ug, b_bar.imag))
    a = jnp.broadcast_to(a_bar, (1, seq, N_GROUPS, STATE))

    def combine(left, right):
        a_l, b_l = left
        a_r, b_r = right
        return a_r * a_l, a_r * b_l + b_r

    _, states = lax.associative_scan(combine, (a, bu), axis=1)
    y = (jnp.einsum('bsgp,gcp->bsgc', states.real, C_re.astype(f32))
         - jnp.einsum('bsgp,gcp->bsgc', states.imag, C_im.astype(f32)))
    y = y.reshape(bsz, seq, D_SSM) + D_skip.astype(f32) * uf
    y = jax.nn.gelu(y)
    y = y * jax.nn.sigmoid(y @ w_glu.astype(f32) + b_glu.astype(f32))
    return y.astype(u.dtype)


def stick_breaking_attention(q, k, v):
    f32 = jnp.float32
    bsz, seq, nh, dh = q.shape
    nb = seq // Q_BLOCK
    qb = q.astype(f32).reshape(bsz, nb, Q_BLOCK, nh, dh).transpose(1, 0, 2, 3, 4)
    kf = k.astype(f32)
    vf = v.astype(f32)
    key_pos = jnp.arange(seq)
    scale = HEAD_DIM ** -0.5

    def one_block(args):
        blk, q_blk = args
        q_pos = blk * Q_BLOCK + jnp.arange(Q_BLOCK)
        z = jnp.einsum('bqhd,bkhd->bhqk', q_blk, kf) * scale
        mask = key_pos[None, :] < q_pos[:, None]
        log_fail = jnp.where(mask, jax.nn.log_sigmoid(-z), 0.0)
        after = lax.cumsum(log_fail, axis=3, reverse=True) - log_fail
        log_w = jax.nn.log_sigmoid(z) + after
        w = jnp.where(mask, jnp.exp(log_w), 0.0)
        return jnp.einsum('bhqk,bkhd->bqhd', w, vf)

    out = lax.map(one_block, (jnp.arange(nb), qb))
    return out.transpose(1, 0, 2, 3, 4).reshape(bsz, seq, nh * dh).astype(q.dtype)


def setup_inputs(seed: int = 0) -> dict:
    key = jax.random.key(seed)
    ks = jax.random.split(key, 22)
    f32 = jnp.float32

    def nrm(k, shape, scale):
        return jax.random.normal(k, shape, f32) * scale

    x = nrm(ks[0], (BATCH, SEQ, D_MODEL), 1.0)
    norm_mix = 1.0 + nrm(ks[1], (DEPTH, D_MODEL), 0.02)
    w_in = nrm(ks[2], (DEPTH, D_MODEL, D_IN), D_MODEL ** -0.5)
    A_re = -0.5 + nrm(ks[3], (DEPTH, N_GROUPS, STATE), 0.01)
    A_im = jnp.pi * jnp.arange(STATE, dtype=f32) + nrm(ks[4], (DEPTH, N_GROUPS, STATE), 0.01)
    log_dt = jax.random.uniform(ks[5], (DEPTH, N_GROUPS), f32, math.log(DT_MIN), math.log(DT_MAX))
    B_re = nrm(ks[6], (DEPTH, N_GROUPS, STATE, SSM_GROUP), (2 * SSM_GROUP) ** -0.5)
    B_im = nrm(ks[7], (DEPTH, N_GROUPS, STATE, SSM_GROUP), (2 * SSM_GROUP) ** -0.5)
    C_re = nrm(ks[8], (DEPTH, N_GROUPS, SSM_GROUP, STATE), STATE ** -0.5)
    C_im = nrm(ks[9], (DEPTH, N_GROUPS, SSM_GROUP, STATE), STATE ** -0.5)
    D_skip = nrm(ks[10], (DEPTH, D_SSM), 1.0)
    w_glu = nrm(ks[11], (DEPTH, D_SSM, D_SSM), D_SSM ** -0.5)
    b_glu = nrm(ks[12], (DEPTH, D_SSM), 0.02)
    w_up_ssm = nrm(ks[13], (DEPTH, D_SSM, D_MODEL), D_SSM ** -0.5)
    w_up_attn = nrm(ks[14], (DEPTH, D_ATTN, D_MODEL), D_ATTN ** -0.5)
    w_gate = nrm(ks[15], (DEPTH, D_MODEL, 2 * D_MODEL), D_MODEL ** -0.5)
    b_gate = nrm(ks[16], (DEPTH, 2 * D_MODEL), 0.02)
    w_out = nrm(ks[17], (DEPTH, D_MODEL, D_MODEL), D_MODEL ** -0.5)
    norm_mlp = 1.0 + nrm(ks[18], (DEPTH, D_MODEL), 0.02)
    w_ff1 = nrm(ks[19], (DEPTH, D_MODEL, D_FF), D_MODEL ** -0.5)
    w_ff2 = nrm(ks[20], (DEPTH, D_FF, D_MODEL), D_FF ** -0.5)
    norm_final = 1.0 + nrm(ks[21], (D_MODEL,), 0.02)
    return {"x": x, "norm_mix": norm_mix, "w_in": w_in, "A_re": A_re, "A_im": A_im,
            "log_dt": log_dt, "B_re": B_re, "B_im": B_im, "C_re": C_re, "C_im": C_im,
            "D_skip": D_skip, "w_glu": w_glu, "b_glu": b_glu, "w_up_ssm": w_up_ssm,
            "w_up_attn": w_up_attn, "w_gate": w_gate, "b_gate": b_gate, "w_out": w_out,
            "norm_mlp": norm_mlp, "w_ff1": w_ff1, "w_ff2": w_ff2, "norm_final": norm_final}


def reference(x, norm_mix, w_in, A_re, A_im, log_dt, B_re, B_im, C_re, C_im, D_skip, w_glu, b_glu,
              w_up_ssm, w_up_attn, w_gate, b_gate, w_out, norm_mlp, w_ff1, w_ff2, norm_final):
    h = x
    bsz, seq, _ = x.shape
    for l in range(DEPTH):
        u = rmsnorm(h, norm_mix[l])
        proj = u @ w_in[l]
        u_ssm, q, k, v = jnp.split(proj, [D_SSM, D_SSM + D_ATTN, D_SSM + 2 * D_ATTN], axis=-1)
        y_ssm = s5_branch(u_ssm, A_re[l], A_im[l], log_dt[l], B_re[l], B_im[l], C_re[l], C_im[l],
                          D_skip[l], w_glu[l], b_glu[l])
        y_attn = stick_breaking_attention(q.reshape(bsz, seq, N_HEADS, HEAD_DIM),
                                          k.reshape(bsz, seq, N_HEADS, HEAD_DIM),
                                          v.reshape(bsz, seq, N_HEADS, HEAD_DIM))
        gates = jax.nn.sigmoid((u @ w_gate[l] + b_gate[l]).astype(jnp.float32)).astype(u.dtype)
        g_ssm, g_attn = jnp.split(gates, 2, axis=-1)
        merged = g_ssm * (y_ssm @ w_up_ssm[l]) + g_attn * (y_attn @ w_up_attn[l])
        h = h + merged @ w_out[l]
        hid = jax.nn.relu(rmsnorm(h, norm_mlp[l]) @ w_ff1[l])
        h = h + (hid * hid) @ w_ff2[l]
    return rmsnorm(h, norm_final)
```

```cpp
#include <hip/hip_runtime.h>
#include <hip/hip_cooperative_groups.h>
#include <cstdio>
#include <cstdint>
namespace cg = cooperative_groups;

namespace pg8 {
#define PG8_LAS __attribute__((address_space(3)))
typedef unsigned short bf16_t;
typedef short bf16x8 __attribute__((ext_vector_type(8)));
typedef float f32x4 __attribute__((ext_vector_type(4)));
typedef float f32x16 __attribute__((ext_vector_type(16)));
typedef unsigned u32x4 __attribute__((ext_vector_type(4)));
typedef unsigned u32x2 __attribute__((ext_vector_type(2)));
constexpr int BM = 256, BK = 64, HALF = 128, HTB = HALF * BK * 2, STAGE_BYTES = 8 * HTB, NXCD = 8, WGM = 8;
__host__ __device__ __forceinline__ int lds_byte(int r, int c) { const int st = (r >> 4) * 2 + (c >> 5), rr = r & 15, cc = c & 31, ob = rr * 64 + cc * 2; return st * 1024 + (ob ^ (((ob >> 9) & 1) << 5)); }
__host__ __device__ __forceinline__ void stage_rc(int b, int& R, int& C) { const int st = b / 1024, sb = b % 1024, swz = sb ^ (((sb >> 9) & 1) << 5); R = (st >> 1) * 16 + swz / 64; C = (st & 1) * 32 + (swz % 64) / 2; }
__host__ __device__ __forceinline__ int perm32(int rho) { const int n = rho >> 4, i = rho & 15; return 8 * (i >> 2) + 4 * n + (i & 3); }
struct Unit { int pm, pn; };
struct Gemm { const bf16_t* A; const bf16_t* Bt; int lda, K; };
struct StaticOrder {
    int nM, nN, nwg, G, c;
    __host__ __device__ void init(int M, int N, int G_, int c_) { nM = M / BM; nN = N / BM; nwg = nM * nN; G = G_; c = c_; }
    __host__ __device__ bool next(int i, Unit& u) const {
        const long L = (long)i * G + c; if (L >= nwg) return false;
        int wgid = (int)L; { const int q = nwg / NXCD, r = nwg % NXCD, xcd = wgid % NXCD, off = wgid / NXCD; wgid = (xcd < r ? xcd * (q + 1) : r * (q + 1) + (xcd - r) * q) + off; }
        const int nig = WGM * nN, gid = wgid / nig, fm = gid * WGM, gsz = (nM - fm) < WGM ? (nM - fm) : WGM;
        u.pm = fm + ((wgid % nig) % gsz); u.pn = (wgid % nig) / gsz; return true;
    }
    __device__ __forceinline__ void a_ready(const Unit&) const {}
    __device__ __forceinline__ void done(const Unit&) const {}
};
struct GroupOrder {
    int nunits, G, c, mode;
    __host__ __device__ bool next(int i, Unit& u) const {
        const int L = i * G + c; if (L >= nunits) return false;
        if (mode == 0) { u.pm = L; u.pn = L >> 2; } else { const int g = L >> 3; u.pm = 4 * g + (L & 3); u.pn = 2 * g + ((L >> 2) & 1); }
        return true;
    }
    __device__ __forceinline__ void a_ready(const Unit&) const {}
    __device__ __forceinline__ void done(const Unit&) const {}
};
__device__ __forceinline__ unsigned cvt_pk_bf16(float lo, float hi) { unsigned r; asm volatile("v_cvt_pk_bf16_f32 %0, %1, %2" : "=v"(r) : "v"(lo), "v"(hi)); return r; }
__device__ __forceinline__ u32x4 pack8(f32x4 a, f32x4 b) { u32x4 w; w.x = cvt_pk_bf16(a[0], a[1]); w.y = cvt_pk_bf16(a[2], a[3]); w.z = cvt_pk_bf16(b[0], b[1]); w.w = cvt_pk_bf16(b[2], b[3]); return w; }
__device__ __forceinline__ void unpack8(u32x4 w, f32x4& a, f32x4& b) {
    a[0] = __uint_as_float(w.x << 16); a[1] = __uint_as_float(w.x & 0xffff0000u); a[2] = __uint_as_float(w.y << 16); a[3] = __uint_as_float(w.y & 0xffff0000u);
    b[0] = __uint_as_float(w.z << 16); b[1] = __uint_as_float(w.z & 0xffff0000u); b[2] = __uint_as_float(w.w << 16); b[3] = __uint_as_float(w.w & 0xffff0000u);
}
__device__ __forceinline__ float sigmoidf_(float x) { return __builtin_amdgcn_rcpf(1.0f + __builtin_amdgcn_exp2f(-1.4426950408889634f * x)); }
__device__ __forceinline__ f32x4 sigmoid4(f32x4 v) { f32x4 o; o[0] = sigmoidf_(v[0]); o[1] = sigmoidf_(v[1]); o[2] = sigmoidf_(v[2]); o[3] = sigmoidf_(v[3]); return o; }

#define EPI_ARGS const f32x4 (&acc)[2][2][4][2], const Unit& u, int wr, int wc, int fr, int fq
#define EPI_LOOP_BEGIN \
    _Pragma("unroll") for (int ai = 0; ai < 2; ++ai) _Pragma("unroll") for (int m = 0; m < 4; ++m) { const int row = u.pm * 256 + ai * 128 + wr * 64 + m * 16 + fr; \
    _Pragma("unroll") for (int bj = 0; bj < 2; ++bj) { const int col = u.pn * 256 + bj * 128 + wc * 32 + 8 * fq; f32x4 v0 = acc[ai][bj][m][0], v1 = acc[ai][bj][m][1];
#define EPI_LOOP_END } }

struct EpiProj {
    static constexpr bool PERM = true, AFTER_DRAIN = false;
    bf16_t* usx; bf16_t* qkv; bf16_t* gates; const float* bgate;
    __device__ __forceinline__ void operator()(EPI_ARGS) const {
        const int colt = u.pn * 256;
        if (colt < 512) {
            EPI_LOOP_BEGIN
                const int g = col >> 4, ci0 = col & 15, chunk = row >> 5, t = row & 31;
                *(u32x4*)(usx + ((size_t)(g * 1024 + chunk)) * 640 + t * 16 + ci0) = pack8(v0, v1);
            EPI_LOOP_END
        } else if (colt < 2048) {
            EPI_LOOP_BEGIN
                *(u32x4*)(qkv + (size_t)row * 1536 + (col - 512)) = pack8(v0, v1);
            EPI_LOOP_END
        } else {
            EPI_LOOP_BEGIN
                const int c2 = col - 2048;
                const f32x4 b0 = *(const f32x4*)(bgate + c2), b1 = *(const f32x4*)(bgate + c2 + 4);
                *(u32x4*)(gates + (size_t)row * 2048 + c2) = pack8(sigmoid4(v0 + b0), sigmoid4(v1 + b1));
            EPI_LOOP_END
        }
    }
};
struct EpiState {
    static constexpr bool PERM = true, AFTER_DRAIN = false;
    float* S;
    __device__ __forceinline__ void operator()(EPI_ARGS) const {
        EPI_LOOP_BEGIN
            if (bj == 0) { const int cl = wc * 32 + 8 * fq; float* d = S + (size_t)row * 128 + cl; *(f32x4*)d = v0; *(f32x4*)(d + 4) = v1; }
            (void)col;
        EPI_LOOP_END
    }
};
__device__ __forceinline__ float gelu_tanh_(float x) { const float u = 0.7978845608028654f * (x + 0.044715f * x * x * x); return x * sigmoidf_(2.0f * u); }
struct EpiSsmY {
    static constexpr bool PERM = true, AFTER_DRAIN = false;
    bf16_t* Y1;
    __device__ __forceinline__ void operator()(EPI_ARGS) const {
        EPI_LOOP_BEGIN
            const int g = row >> 10, chunkg = row & 1023, cl = (col & 511), t = cl >> 4, co0 = cl & 15;
            f32x4 a, b;
#pragma unroll
            for (int e = 0; e < 4; ++e) { a[e] = gelu_tanh_(v0[e]); b[e] = gelu_tanh_(v1[e]); }
            *(u32x4*)(Y1 + (size_t)(chunkg * 32 + t) * 512 + g * 16 + co0) = pack8(a, b);
        EPI_LOOP_END
    }
};
struct EpiGlu {
    static constexpr bool PERM = true, AFTER_DRAIN = false;
    const bf16_t* Y1; bf16_t* Y2; const float* bglu;
    __device__ __forceinline__ void operator()(EPI_ARGS) const {
        EPI_LOOP_BEGIN
            const f32x4 b0 = *(const f32x4*)(bglu + col), b1 = *(const f32x4*)(bglu + col + 4);
            f32x4 y0, y1; unpack8(*(const u32x4*)(Y1 + (size_t)row * 512 + col), y0, y1);
            *(u32x4*)(Y2 + (size_t)row * 512 + col) = pack8(y0 * sigmoid4(v0 + b0), y1 * sigmoid4(v1 + b1));
        EPI_LOOP_END
    }
};
template <bool ADD> struct EpiUp {
    static constexpr bool PERM = true, AFTER_DRAIN = false;
    const bf16_t* gates; bf16_t* T1; int goff;
    __device__ __forceinline__ void operator()(EPI_ARGS) const {
        EPI_LOOP_BEGIN
            f32x4 g0, g1; unpack8(*(const u32x4*)(gates + (size_t)row * 2048 + goff + col), g0, g1);
            f32x4 r0 = g0 * v0, r1 = g1 * v1;
            bf16_t* d = T1 + (size_t)row * 1024 + col;
            if (ADD) { f32x4 t0, t1; unpack8(*(const u32x4*)d, t0, t1); r0 += t0; r1 += t1; }
            *(u32x4*)d = pack8(r0, r1);
        EPI_LOOP_END
    }
};
struct EpiOut {
    static constexpr bool PERM = true, AFTER_DRAIN = false;
    const float* x; float* hout; bf16_t* HN; const float* gn; float* rowss;
    __device__ __forceinline__ void operator()(EPI_ARGS) const {
#pragma unroll
        for (int ai = 0; ai < 2; ++ai)
#pragma unroll
            for (int m = 0; m < 4; ++m) {
                const int row = u.pm * 256 + ai * 128 + wr * 64 + m * 16 + fr; float ss = 0.f;
#pragma unroll
                for (int bj = 0; bj < 2; ++bj) {
                    const int col = u.pn * 256 + bj * 128 + wc * 32 + 8 * fq; const size_t o = (size_t)row * 1024 + col;
                    const f32x4 h0 = *(const f32x4*)(x + o) + acc[ai][bj][m][0], h1 = *(const f32x4*)(x + o + 4) + acc[ai][bj][m][1];
                    *(f32x4*)(hout + o) = h0; *(f32x4*)(hout + o + 4) = h1;
                    const f32x4 n0 = *(const f32x4*)(gn + col), n1 = *(const f32x4*)(gn + col + 4);
                    *(u32x4*)(HN + o) = pack8(h0 * n0, h1 * n1);
                    const f32x4 q0 = h0 * h0, q1 = h1 * h1; ss += (q0[0] + q0[1]) + (q0[2] + q0[3]) + (q1[0] + q1[1]) + (q1[2] + q1[3]);
                }
                ss += __shfl_xor(ss, 16); ss += __shfl_xor(ss, 32);
                if (fq == 0) atomicAdd(rowss + row, ss);
            }
    }
};
struct EpiFf1 {
    static constexpr bool PERM = true, AFTER_DRAIN = false;
    const float* rowss; bf16_t* HID;
    __device__ __forceinline__ void operator()(EPI_ARGS) const {
#pragma unroll
        for (int ai = 0; ai < 2; ++ai)
#pragma unroll
            for (int m = 0; m < 4; ++m) {
                const int row = u.pm * 256 + ai * 128 + wr * 64 + m * 16 + fr;
                const float r2 = 1.0f / (rowss[row] * (1.0f / 1024.0f) + 1e-6f);
#pragma unroll
                for (int bj = 0; bj < 2; ++bj) {
                    const int col = u.pn * 256 + bj * 128 + wc * 32 + 8 * fq;
                    f32x4 a = acc[ai][bj][m][0], b = acc[ai][bj][m][1];
#pragma unroll
                    for (int e = 0; e < 4; ++e) { const float p = fmaxf(a[e], 0.f), q = fmaxf(b[e], 0.f); a[e] = p * p * r2; b[e] = q * q * r2; }
                    *(u32x4*)(HID + (size_t)row * 4096 + col) = pack8(a, b);
                }
            }
    }
};
struct EpiFf2 {
    static constexpr bool PERM = true, AFTER_DRAIN = false;
    float* h; float* rowss;
    __device__ __forceinline__ void operator()(EPI_ARGS) const {
#pragma unroll
        for (int ai = 0; ai < 2; ++ai)
#pragma unroll
            for (int m = 0; m < 4; ++m) {
                const int row = u.pm * 256 + ai * 128 + wr * 64 + m * 16 + fr; float ss = 0.f;
#pragma unroll
                for (int bj = 0; bj < 2; ++bj) {
                    const int col = u.pn * 256 + bj * 128 + wc * 32 + 8 * fq; const size_t o = (size_t)row * 1024 + col;
                    const f32x4 h0 = *(const f32x4*)(h + o) + acc[ai][bj][m][0], h1 = *(const f32x4*)(h + o + 4) + acc[ai][bj][m][1];
                    *(f32x4*)(h + o) = h0; *(f32x4*)(h + o + 4) = h1;
                    const f32x4 q0 = h0 * h0, q1 = h1 * h1; ss += (q0[0] + q0[1]) + (q0[2] + q0[3]) + (q1[0] + q1[1]) + (q1[2] + q1[3]);
                }
                ss += __shfl_xor(ss, 16); ss += __shfl_xor(ss, 32);
                if (fq == 0) atomicAdd(rowss + row, ss);
            }
    }
};

template <class Epi, class Sched, bool ALIGN_EPI = false, bool SP2 = false>
__device__ __forceinline__ void gemm_phase(PG8_LAS unsigned char* lds, const Gemm g, const Sched& S, const Epi& E) {
    int tid_ = threadIdx.x; asm volatile("" : "+v"(tid_));
    const int tid = tid_, wid = __builtin_amdgcn_readfirstlane(tid >> 6), lane = tid & 63, wr = wid >> 2, wc = wid & 3, fr = lane & 15, fq = lane >> 4;
    const int K = g.K, nt = K / BK;
    unsigned voffA[2], voffB[2];
#pragma unroll
    for (int i = 0; i < 2; ++i) { int R, C; stage_rc(tid * 16 + i * 8192, R, C); const int Rb = Epi::PERM ? ((R & ~31) + perm32(R & 31)) : R;
        voffA[i] = (unsigned)(R * g.lda + C) * 2u; voffB[i] = (unsigned)(Rb * K + C) * 2u; }
    const size_t kstep = (size_t)(BK * 2);
    const size_t hstepA = (size_t)HALF * g.lda * 2, hstepB = (size_t)HALF * K * 2;
    const size_t tstepA = 2 * hstepA, tstepB = 2 * hstepB;
    const unsigned ldsw = (unsigned)wid * 1024u;
    const int aoff = lds_byte(wr * 64 + fr, fq * 8), boff = lds_byte(wc * 32 + fr, fq * 8);
#define PG8_SA(b, h) (((b) * 2 + (h)) * HTB)
#define PG8_SB(b, h) ((4 + (b) * 2 + (h)) * HTB)
#define PG8_STAGE(bufoff, gbase, voff) do { _Pragma("unroll") for (int _i = 0; _i < 2; ++_i) \
        __builtin_amdgcn_global_load_lds((const unsigned*)((const char*)(gbase) + (voff)[_i]), (PG8_LAS unsigned*)(lds + (bufoff) + ldsw + _i * 8192), 16, 0, 0); } while (0)
#define PG8_LDA(dst, b, h) do { _Pragma("unroll") for (int m = 0; m < 4; ++m) _Pragma("unroll") for (int k = 0; k < 2; ++k) dst[m][k] = *(const PG8_LAS bf16x8*)(lds + PG8_SA(b, h) + aoff + m * 2048 + k * 1024); } while (0)
#define PG8_LDB(dst, b, h) do { _Pragma("unroll") for (int n = 0; n < 2; ++n) _Pragma("unroll") for (int k = 0; k < 2; ++k) dst[n][k] = *(const PG8_LAS bf16x8*)(lds + PG8_SB(b, h) + boff + n * 2048 + k * 1024); } while (0)
#define PG8_MMA(ai, bj, At, Bt) do { __builtin_amdgcn_s_setprio(1); _Pragma("unroll") for (int m = 0; m < 4; ++m) _Pragma("unroll") for (int n = 0; n < 2; ++n) _Pragma("unroll") for (int k = 0; k < 2; ++k) \
        acc[ai][bj][m][n] = __builtin_amdgcn_mfma_f32_16x16x32_bf16(Bt[n][k], At[m][k], acc[ai][bj][m][n], 0, 0, 0); __builtin_amdgcn_s_setprio(0); } while (0)
#define PG8_WAIT_V(n) asm volatile("s_waitcnt vmcnt(" #n ")" ::: "memory")
#define PG8_WAIT_L(n) asm volatile("s_waitcnt lgkmcnt(" #n ")" ::: "memory")
#define PG8_BAR __builtin_amdgcn_s_barrier()
#define PG8_SCHED __builtin_amdgcn_sched_barrier(0)
    Unit cur, nxt; int ui = 0;
    if (!S.next(0, cur)) return;
    f32x4 acc[2][2][4][2];
#pragma unroll
    for (int a = 0; a < 2; ++a)
#pragma unroll
        for (int b = 0; b < 2; ++b)
#pragma unroll
            for (int m = 0; m < 4; ++m)
#pragma unroll
                for (int n = 0; n < 2; ++n) acc[a][b][m][n] = (f32x4){0.f, 0.f, 0.f, 0.f};
    bf16x8 At[4][2], B0[2][2], B1[2][2];
    const char* cA = (const char*)g.A + (size_t)cur.pm * tstepA; const char* cB = (const char*)g.Bt + (size_t)cur.pn * tstepB;
    S.a_ready(cur);
    if constexpr (SP2) {
        PG8_STAGE(PG8_SB(0, 0), cB, voffB); PG8_STAGE(PG8_SB(0, 1), cB + hstepB, voffB); PG8_STAGE(PG8_SA(0, 0), cA, voffA); PG8_STAGE(PG8_SA(0, 1), cA + hstepA, voffA);
        if (wr == 1) PG8_BAR;
        PG8_WAIT_V(2); PG8_BAR;
        PG8_STAGE(PG8_SB(1, 0), cB + kstep, voffB); PG8_STAGE(PG8_SA(1, 0), cA + kstep, voffA); PG8_STAGE(PG8_SB(1, 1), cB + hstepB + kstep, voffB);
        PG8_WAIT_V(6); PG8_BAR;
    } else {
        PG8_STAGE(PG8_SB(0, 0), cB, voffB); PG8_STAGE(PG8_SA(0, 0), cA, voffA); PG8_STAGE(PG8_SB(0, 1), cB + hstepB, voffB); PG8_STAGE(PG8_SA(0, 1), cA + hstepA, voffA);
        if (wr == 1) PG8_BAR;
        PG8_WAIT_V(4); PG8_BAR;
        PG8_STAGE(PG8_SB(1, 0), cB + kstep, voffB); PG8_STAGE(PG8_SA(1, 0), cA + kstep, voffA); PG8_STAGE(PG8_SB(1, 1), cB + hstepB + kstep, voffB);
        PG8_WAIT_V(6); PG8_BAR;
    }
    for (;;) {
        const bool has_next = S.next(ui + 1, nxt);
        const char* nA = has_next ? (const char*)g.A + (size_t)nxt.pm * tstepA : cA; const char* nB = has_next ? (const char*)g.Bt + (size_t)nxt.pn * tstepB : cB;
        for (int t = 0; t < nt; t += 2) {
            const bool last = (t == nt - 2);
            const char* a1 = cA + (size_t)(t + 1) * kstep;
            const char* a2 = last ? nA : cA + (size_t)(t + 2) * kstep; const char* b2 = last ? nB : cB + (size_t)(t + 2) * kstep;
            const char* a3 = a2 + kstep; const char* b3 = b2 + kstep;
            if (last && has_next) S.a_ready(nxt);
            if constexpr (SP2) {
            PG8_LDB(B0, 0, 0); PG8_LDB(B1, 0, 1); PG8_SCHED; PG8_LDA(At, 0, 0); PG8_STAGE(PG8_SA(1, 1), a1 + hstepA, voffA);
            PG8_WAIT_V(8); PG8_WAIT_L(0); PG8_BAR; PG8_MMA(0, 0, At, B0); PG8_MMA(0, 1, At, B1); PG8_BAR; PG8_SCHED;
            PG8_LDA(At, 0, 1); PG8_STAGE(PG8_SB(0, 0), b2, voffB); PG8_STAGE(PG8_SB(0, 1), b2 + hstepB, voffB); PG8_STAGE(PG8_SA(0, 0), a2, voffA);
            PG8_WAIT_V(8); PG8_WAIT_L(0); PG8_BAR; PG8_MMA(1, 0, At, B0); PG8_MMA(1, 1, At, B1); PG8_BAR; PG8_SCHED;
            PG8_LDB(B0, 1, 0); PG8_LDB(B1, 1, 1); PG8_SCHED; PG8_LDA(At, 1, 0); PG8_STAGE(PG8_SA(0, 1), a2 + hstepA, voffA);
            PG8_WAIT_V(8); PG8_WAIT_L(0); PG8_BAR; PG8_MMA(0, 0, At, B0); PG8_MMA(0, 1, At, B1); PG8_BAR; PG8_SCHED;
            PG8_LDA(At, 1, 1); PG8_STAGE(PG8_SB(1, 0), b3, voffB); PG8_STAGE(PG8_SB(1, 1), b3 + hstepB, voffB); PG8_STAGE(PG8_SA(1, 0), a3, voffA);
            PG8_WAIT_V(8); PG8_WAIT_L(0); PG8_BAR; PG8_MMA(1, 0, At, B0); PG8_MMA(1, 1, At, B1); PG8_BAR; PG8_SCHED;
            } else {
            PG8_LDB(B0, 0, 0); PG8_SCHED; PG8_LDA(At, 0, 0); PG8_STAGE(PG8_SA(1, 1), a1 + hstepA, voffA);
            PG8_WAIT_L(8); PG8_BAR; PG8_WAIT_L(0); PG8_MMA(0, 0, At, B0); PG8_BAR; PG8_SCHED;
            PG8_LDB(B1, 0, 1); PG8_STAGE(PG8_SB(0, 0), b2, voffB);
            PG8_BAR; PG8_WAIT_L(0); PG8_MMA(0, 1, At, B1); PG8_BAR;
            PG8_LDA(At, 0, 1); PG8_STAGE(PG8_SA(0, 0), a2, voffA);
            PG8_BAR; PG8_WAIT_L(0); PG8_MMA(1, 0, At, B0); PG8_BAR; PG8_SCHED;
            PG8_STAGE(PG8_SB(0, 1), b2 + hstepB, voffB);
            PG8_WAIT_V(6); PG8_BAR; PG8_MMA(1, 1, At, B1); PG8_BAR;
            PG8_LDB(B0, 1, 0); PG8_SCHED; PG8_LDA(At, 1, 0); PG8_STAGE(PG8_SA(0, 1), a2 + hstepA, voffA);
            PG8_WAIT_L(8); PG8_BAR; PG8_WAIT_L(0); PG8_MMA(0, 0, At, B0); PG8_BAR; PG8_SCHED;
            PG8_LDB(B1, 1, 1); PG8_STAGE(PG8_SB(1, 0), b3, voffB);
            PG8_BAR; PG8_WAIT_L(0); PG8_MMA(0, 1, At, B1); PG8_BAR;
            PG8_LDA(At, 1, 1); PG8_STAGE(PG8_SA(1, 0), a3, voffA);
            PG8_BAR; PG8_WAIT_L(0); PG8_MMA(1, 0, At, B0); PG8_BAR; PG8_SCHED;
            PG8_STAGE(PG8_SB(1, 1), b3 + hstepB, voffB);
            PG8_WAIT_V(6); PG8_BAR; PG8_MMA(1, 1, At, B1); PG8_BAR;
            }
        }
        if constexpr (ALIGN_EPI) { if (wr == 0) PG8_BAR; }
        if constexpr (!Epi::AFTER_DRAIN) { E(acc, cur, wr, wc, fr, fq); S.done(cur); }
        if (!has_next) break;
#pragma unroll
        for (int a = 0; a < 2; ++a)
#pragma unroll
            for (int b = 0; b < 2; ++b)
#pragma unroll
                for (int m = 0; m < 4; ++m)
#pragma unroll
                    for (int n = 0; n < 2; ++n) acc[a][b][m][n] = (f32x4){0.f, 0.f, 0.f, 0.f};
        cur = nxt; cA = nA; cB = nB; ++ui;
        if constexpr (ALIGN_EPI) { if (wr == 1) PG8_BAR; }
    }
    PG8_WAIT_V(0);
    if constexpr (!ALIGN_EPI) { if (wr == 0) PG8_BAR; }
    PG8_BAR;
    if constexpr (Epi::AFTER_DRAIN) { E.fused(acc, cur, wr, wc, fr, fq, lds, wid, lane); S.done(cur); }
#undef PG8_SA
#undef PG8_SB
#undef PG8_STAGE
#undef PG8_LDA
#undef PG8_LDB
#undef PG8_MMA
#undef PG8_WAIT_V
#undef PG8_WAIT_L
#undef PG8_BAR
#undef PG8_SCHED
}
}

using pg8::bf16_t; using pg8::bf16x8; using pg8::f32x4; using pg8::f32x16; using pg8::u32x4; using pg8::u32x2;
#define LAS __attribute__((address_space(3)))
typedef short v4i16_t __attribute__((ext_vector_type(4)));

constexpr int DM = 1024, NBATCH = 4, SEQ = 8192, M = NBATCH * SEQ, DSSM = 512, NG = 32, NST = 64, NHEAD = 8, DFF = 4096;
constexpr int LCH = 32, NCHG = M / LCH  , KX = 640;
constexpr float EPSN = 1e-6f;
constexpr size_t MiB = 1u << 20;
constexpr size_t WS_CTL = 0;
constexpr size_t WS_WCAT = 1 * MiB, WS_WGLU = 9 * MiB, WS_WUPS = 10 * MiB, WS_WUPA = 11 * MiB, WS_WOUT = 12 * MiB, WS_W1 = 14 * MiB, WS_W2 = 22 * MiB;
constexpr size_t WS_TG = 32 * MiB, WS_HH = 52 * MiB, WS_APOW = 60 * MiB, WS_S = 64 * MiB, WS_USX = 84 * MiB;
constexpr size_t WS_XN = 128 * MiB;
constexpr size_t WS_QKV = 192 * MiB;
constexpr size_t WS_GATES = 288 * MiB, WS_Y1 = 416 * MiB, WS_Y2 = 448 * MiB, WS_YATT = 480 * MiB;
constexpr size_t WS_HID = 256 * MiB, WS_END = 512 * MiB;
constexpr int LDS_BYTES = 147456;

__device__ __forceinline__ unsigned f2bf(float f) { unsigned u = __builtin_bit_cast(unsigned, f); return (u + 0x7fffu + ((u >> 16) & 1u)) >> 16; }
__device__ __forceinline__ unsigned pk2(float lo, float hi) { return f2bf(lo) | (f2bf(hi) << 16); }
__device__ __forceinline__ float wave_sum(float v) {
#pragma unroll
    for (int o = 1; o < 64; o <<= 1) v += __shfl_xor(v, o);
    return v;
}
__device__ __forceinline__ void transpose_item(const float* __restrict__ W, int K, int N, bf16_t* __restrict__ WT, int row_off, LAS float* scr, int item, int lane) {
    const int nblk = N / 32, kb = item / nblk, nb = item % nblk, k0 = 64 * kb, n0 = 32 * nb;
#pragma unroll 8
    for (int i = 0; i < 32; ++i) { const int kk = 2 * i + (lane >> 5); scr[kk * 33 + (lane & 31)] = W[(size_t)(k0 + kk) * N + n0 + (lane & 31)]; }
    asm volatile("s_waitcnt lgkmcnt(0)" ::: "memory");
    const int c = lane & 7;
#pragma unroll
    for (int j = 0; j < 4; ++j) { const int n = (lane >> 3) + 8 * j; const LAS float* s = scr + (8 * c) * 33 + n;
        u32x4 o; o.x = pk2(s[0 * 33], s[1 * 33]); o.y = pk2(s[2 * 33], s[3 * 33]); o.z = pk2(s[4 * 33], s[5 * 33]); o.w = pk2(s[6 * 33], s[7 * 33]);
        *(u32x4*)(WT + (size_t)(row_off + n0 + n) * K + k0 + 8 * c) = o; }
    asm volatile("s_waitcnt lgkmcnt(0)" ::: "memory");
}

struct Args { const float* in[22]; float* out; unsigned char* ws; };
enum { I_X = 0, I_NMIX, I_WIN, I_ARE, I_AIM, I_LOGDT, I_BRE, I_BIM, I_CRE, I_CIM, I_DSKIP, I_WGLU, I_BGLU, I_WUPS, I_WUPA, I_WGATE, I_BGATE, I_WOUT, I_NMLP, I_W1, I_W2, I_NFIN };

__device__ __forceinline__ void ssm_precompute_item(LAS unsigned char* lds, const Args& a, int item) {
    const int g = item >> 3, part = item & 7, tid = threadIdx.x;
    LAS float* E = (LAS float*)lds;
    LAS float* BB = E + 33 * 64 * 2;
    LAS float* CC = BB + 64 * 16 * 2;
    LAS float* KT = CC + 16 * 64 * 2;
    const float* A_re = a.in[I_ARE] + g * 64; const float* A_im = a.in[I_AIM] + g * 64;
    const float dt = expf(a.in[I_LOGDT][g]);
    for (int idx = tid; idx < 33 * 64; idx += 512) { const int n = idx >> 6, p = idx & 63; const float ar = A_re[p] * dt, ai = A_im[p] * dt;
        const float mag = expf(ar * (float)n), th = ai * (float)n; E[idx * 2] = mag * cosf(th); E[idx * 2 + 1] = mag * sinf(th); }
    for (int idx = tid; idx < 64 * 16; idx += 512) { const int p = idx >> 4, ci = idx & 15; const float lr = A_re[p], li = A_im[p], ar = lr * dt, ai = li * dt;
        const float mag = expf(ar), are = mag * cosf(ai) - 1.0f, aim = mag * sinf(ai), den = 1.0f / (lr * lr + li * li);
        const float cfr = (are * lr + aim * li) * den, cfi = (aim * lr - are * li) * den;
        const float br = a.in[I_BRE][(size_t)(g * 64 + p) * 16 + ci], bi = a.in[I_BIM][(size_t)(g * 64 + p) * 16 + ci];
        BB[idx * 2] = cfr * br - cfi * bi; BB[idx * 2 + 1] = cfr * bi + cfi * br; }
    for (int idx = tid; idx < 16 * 64; idx += 512) { CC[idx * 2] = a.in[I_CRE][(size_t)g * 1024 + idx]; CC[idx * 2 + 1] = a.in[I_CIM][(size_t)g * 1024 + idx]; }
    __syncthreads();
    {
        const int tau = tid >> 4, co = tid & 15;
        if (tau <= 4 * part + 3) {
            float acc[16];
#pragma unroll
            for (int i = 0; i < 16; ++i) acc[i] = 0.f;
            for (int p = 0; p < 64; ++p) {
                const float cr = CC[(co * 64 + p) * 2], ci_ = CC[(co * 64 + p) * 2 + 1], er = E[(tau * 64 + p) * 2], ei = E[(tau * 64 + p) * 2 + 1];
                const float wr = cr * er - ci_ * ei, wi = cr * ei + ci_ * er;
#pragma unroll
                for (int i = 0; i < 16; ++i) acc[i] += wr * BB[(p * 16 + i) * 2] - wi * BB[(p * 16 + i) * 2 + 1];
            }
#pragma unroll
            for (int i = 0; i < 16; ++i) KT[(tau * 16 + co) * 16 + i] = acc[i];
        }
    }
    __syncthreads();
    bf16_t* TG = (bf16_t*)(a.ws + WS_TG); bf16_t* HH = (bf16_t*)(a.ws + WS_HH);
    for (int idx = tid; idx < 64 * 80; idx += 512) {
        const int rl = idx / 80, ch = idx - rl * 80, n = part * 64 + rl, t = n >> 4, co = n & 15;
        float v[8];
        if (ch < 64) {
            const int s = ch >> 1, ci0 = (ch & 1) * 8;
#pragma unroll
            for (int e = 0; e < 8; ++e) { float x = 0.f; if (s <= t) x = KT[((t - s) * 16 + co) * 16 + ci0 + e]; if (s == t && ci0 + e == co) x += a.in[I_DSKIP][g * 16 + co]; v[e] = x; }
        } else {
#pragma unroll
            for (int e = 0; e < 8; ++e) { const int j = (ch - 64) * 8 + e, p = j & 63; const float cr = CC[(co * 64 + p) * 2], ci_ = CC[(co * 64 + p) * 2 + 1], er = E[((t + 1) * 64 + p) * 2], ei = E[((t + 1) * 64 + p) * 2 + 1];
                v[e] = (j < 64) ? (cr * er - ci_ * ei) : -(cr * ei + ci_ * er); }
        }
        u32x4 o; o.x = pk2(v[0], v[1]); o.y = pk2(v[2], v[3]); o.z = pk2(v[4], v[5]); o.w = pk2(v[6], v[7]);
        *(u32x4*)(TG + ((size_t)(g * 512 + n)) * KX + ch * 8) = o;
    }
    for (int idx = tid; idx < 32 * 64; idx += 512) {
        const int rl = idx >> 6, ch = idx & 63, jr = part * 32 + rl, s = ch >> 1, ci0 = (ch & 1) * 8;
        float v[8];
#pragma unroll
        for (int e = 0; e < 8; ++e) { float x = 0.f;
            if (jr < 128) { const int p = jr & 63; const float er = E[((31 - s) * 64 + p) * 2], ei = E[((31 - s) * 64 + p) * 2 + 1], br = BB[(p * 16 + ci0 + e) * 2], bi = BB[(p * 16 + ci0 + e) * 2 + 1];
                x = (jr < 64) ? (er * br - ei * bi) : (er * bi + ei * br); }
            v[e] = x; }
        u32x4 o; o.x = pk2(v[0], v[1]); o.y = pk2(v[2], v[3]); o.z = pk2(v[4], v[5]); o.w = pk2(v[6], v[7]);
        *(u32x4*)(HH + ((size_t)(g * 256 + jr)) * 512 + ch * 8) = o;
    }
    if (part == 0 && tid < 64) { float* AP = (float*)(a.ws + WS_APOW); AP[(g * 64 + tid) * 2] = E[(32 * 64 + tid) * 2]; AP[(g * 64 + tid) * 2 + 1] = E[(32 * 64 + tid) * 2 + 1]; }
    __syncthreads();
}

__device__ __forceinline__ void prologue(LAS unsigned char* lds, const Args& a) {
    const int tid = threadIdx.x, lane = tid & 63, wave = tid >> 6, G = gridDim.x;
    { float* rs = (float*)(a.ws + WS_CTL); for (int i = blockIdx.x * 512 + tid; i < 2 * M; i += G * 512) rs[i] = 0.f; }
    for (int it = blockIdx.x; it < 256; it += G) ssm_precompute_item(lds, a, it);
    LAS float* scr = (LAS float*)(lds + wave * 16384);
    const int gw = blockIdx.x * 8 + wave, NGW = G * 8;
    bf16_t* WCAT = (bf16_t*)(a.ws + WS_WCAT);
    constexpr int I_IN = 16 * 64, I_GT = 16 * 64, I_GLU = 8 * 16, I_UPS = 8 * 32, I_UPA = 8 * 32, I_OUT = 16 * 32, I_F1 = 16 * 128, I_F2 = 64 * 32;
    constexpr int NITEMS = I_IN + I_GT + I_GLU + I_UPS + I_UPA + I_OUT + I_F1 + I_F2;
    for (int it = gw; it < NITEMS; it += NGW) {
        int r = it;
        if (r < I_IN) { transpose_item(a.in[I_WIN], 1024, 2048, WCAT, 0, scr, r, lane); continue; } r -= I_IN;
        if (r < I_GT) { transpose_item(a.in[I_WGATE], 1024, 2048, WCAT, 2048, scr, r, lane); continue; } r -= I_GT;
        if (r < I_GLU) { transpose_item(a.in[I_WGLU], 512, 512, (bf16_t*)(a.ws + WS_WGLU), 0, scr, r, lane); continue; } r -= I_GLU;
        if (r < I_UPS) { transpose_item(a.in[I_WUPS], 512, 1024, (bf16_t*)(a.ws + WS_WUPS), 0, scr, r, lane); continue; } r -= I_UPS;
        if (r < I_UPA) { transpose_item(a.in[I_WUPA], 512, 1024, (bf16_t*)(a.ws + WS_WUPA), 0, scr, r, lane); continue; } r -= I_UPA;
        if (r < I_OUT) { transpose_item(a.in[I_WOUT], 1024, 1024, (bf16_t*)(a.ws + WS_WOUT), 0, scr, r, lane); continue; } r -= I_OUT;
        if (r < I_F1) { transpose_item(a.in[I_W1], 1024, 4096, (bf16_t*)(a.ws + WS_W1), 0, scr, r, lane); continue; } r -= I_F1;
        transpose_item(a.in[I_W2], 4096, 1024, (bf16_t*)(a.ws + WS_W2), 0, scr, r, lane);
    }
    const float* x = a.in[I_X]; const float* gm = a.in[I_NMIX]; bf16_t* XN = (bf16_t*)(a.ws + WS_XN);
    f32x4 gv[4];
#pragma unroll
    for (int j = 0; j < 4; ++j) gv[j] = *((const f32x4*)gm + 64 * j + lane);
    for (int m = gw; m < M; m += NGW) {
        const f32x4* xr = (const f32x4*)(x + (size_t)m * DM) + lane; f32x4 v[4]; float s = 0.f;
#pragma unroll
        for (int j = 0; j < 4; ++j) { v[j] = xr[64 * j]; s += (v[j][0] * v[j][0] + v[j][1] * v[j][1]) + (v[j][2] * v[j][2] + v[j][3] * v[j][3]); }
        const float rstd = 1.0f / sqrtf(wave_sum(s) * (1.0f / DM) + EPSN);
        u32x2* o8 = (u32x2*)(XN + (size_t)m * DM) + lane;
#pragma unroll
        for (int j = 0; j < 4; ++j) { u32x2 o; o.x = pk2(v[j][0] * rstd * gv[j][0], v[j][1] * rstd * gv[j][1]); o.y = pk2(v[j][2] * rstd * gv[j][2], v[j][3] * rstd * gv[j][3]); o8[64 * j] = o; }
    }
}

__device__ __forceinline__ void scan_phase(LAS unsigned char* lds, const Args& a) {
    int tid_ = threadIdx.x; asm volatile("" : "+v"(tid_));
    const int tid = tid_, lane = tid & 63, w = __builtin_amdgcn_readfirstlane(tid >> 6);
    const float* S = (const float*)(a.ws + WS_S); const float* AP = (const float*)(a.ws + WS_APOW); bf16_t* USX = (bf16_t*)(a.ws + WS_USX);
    LAS float* seg = (LAS float*)lds;
    for (int it = blockIdx.x; it < 128; it += gridDim.x) {
        const int g = it >> 2, b = it & 3, p = lane;
        const float alr = AP[(g * 64 + p) * 2], ali = AP[(g * 64 + p) * 2 + 1];
        const size_t row0 = (size_t)g * 1024 + b * 256 + 32 * w;
        float sr[32], si[32];
#pragma unroll
        for (int i = 0; i < 32; ++i) { sr[i] = S[(row0 + i) * 128 + p]; si[i] = S[(row0 + i) * 128 + 64 + p]; }
        float xr = 0.f, xi = 0.f;
#pragma unroll
        for (int i = 0; i < 32; ++i) { const float tr = xr, ti = xi; const float nr = alr * xr - ali * xi + sr[i], ni = alr * xi + ali * xr + si[i]; xr = nr; xi = ni; sr[i] = tr; si[i] = ti; }
        seg[(w * 64 + p) * 2] = xr; seg[(w * 64 + p) * 2 + 1] = xi;
        float a32r = alr, a32i = ali;
#pragma unroll
        for (int k = 0; k < 5; ++k) { const float tr = a32r * a32r - a32i * a32i, ti = 2.f * a32r * a32i; a32r = tr; a32i = ti; }
        __syncthreads();
        float x0r = 0.f, x0i = 0.f;
        for (int ww = 0; ww < w; ++ww) { const float er = seg[(ww * 64 + p) * 2], ei = seg[(ww * 64 + p) * 2 + 1]; const float nr = a32r * x0r - a32i * x0i + er, ni = a32r * x0i + a32i * x0r + ei; x0r = nr; x0i = ni; }
        float pr = 1.f, pi = 0.f;
#pragma unroll
        for (int i = 0; i < 32; ++i) {
            const float vr = sr[i] + pr * x0r - pi * x0i, vi = si[i] + pr * x0i + pi * x0r;
            bf16_t* d = USX + (row0 + i) * KX + 512 + p; d[0] = (bf16_t)f2bf(vr); d[64] = (bf16_t)f2bf(vi);
            const float tr = pr * alr - pi * ali, ti = pr * ali + pi * alr; pr = tr; pi = ti;
        }
        __syncthreads();
    }
}

__device__ __forceinline__ void attn_phase(LAS unsigned char* lds, const Args& a) {
    int tid_ = threadIdx.x; asm volatile("" : "+v"(tid_));
    const int tid = tid_, lane = tid & 63, w = __builtin_amdgcn_readfirstlane(tid >> 6), l31 = lane & 31, hi = lane >> 5;
    const bf16_t* __restrict__ QKV = (const bf16_t*)(a.ws + WS_QKV); bf16_t* __restrict__ YATT = (bf16_t*)(a.ws + WS_YATT);
    constexpr float LOG2E = 1.4426950408889634f, LN2 = 0.6931471805599453f, NEG_INF = -__builtin_inff();
    const int skey = tid >> 3, sch = tid & 7;
    const unsigned kst = skey * 128 + ((sch ^ ((skey >> 1) & 7)) << 4), vst = 8192 + skey * 128 + ((sch ^ (((skey >> 1) & 1) << 2)) << 4);
    unsigned koff[4];
#pragma unroll
    for (int s = 0; s < 4; ++s) koff[s] = l31 * 128 + (((2 * s + hi) ^ ((l31 >> 1) & 7)) << 4);
    const int tq = (lane & 15) >> 2, tc2 = 2 * ((lane >> 4) & 1) + ((lane & 3) >> 1), tb = (tq >> 1) & 1;
    const unsigned vbase = 8192 + (4 * hi + tq) * 128 + tc2 * 16 + (lane & 1) * 8;
    for (int L = blockIdx.x; L < 1024; L += gridDim.x) {
        const int bh = L & 31, qb = 31 - (L >> 5), b = bh >> 3, h = bh & 7, q0 = qb * 256;
        const size_t rowbase = (size_t)b * SEQ;
        const int qmin = q0 + 32 * w, qpos = qmin + l31;
        bf16x8 qf[4];
        { const bf16_t* qp = QKV + (rowbase + qpos) * 1536 + h * 64 + 8 * hi;
#pragma unroll
          for (int s = 0; s < 4; ++s) qf[s] = *(const bf16x8*)(qp + 16 * s); }
        f32x16 o0, o1;
#pragma unroll
        for (int r = 0; r < 16; ++r) { o0[r] = 0.f; o1[r] = 0.f; }
        float R = 0.f; bool wdone = false;
        const int jmax = qb * 4 + 3;
        const bf16_t* kvp = QKV + (rowbase + skey) * 1536 + 512 + h * 64 + sch * 8;
        u32x4 kreg = *(const u32x4*)(kvp + (size_t)jmax * 64 * 1536), vreg = *(const u32x4*)(kvp + (size_t)jmax * 64 * 1536 + 512);
        *(LAS u32x4*)(lds + kst) = kreg; *(LAS u32x4*)(lds + vst) = vreg;
        __syncthreads();
        int buf = 0;
        for (int j = jmax; j >= 0; --j) {
            if (j > 0) { kreg = *(const u32x4*)(kvp + (size_t)(j - 1) * 64 * 1536); vreg = *(const u32x4*)(kvp + (size_t)(j - 1) * 64 * 1536 + 512); }
            const int kbase = 64 * j;
            if (kbase < qmin + 31 && !wdone) {
                const LAS unsigned char* kb = lds + buf * 16384;
                f32x16 p0, p1;
#pragma unroll
                for (int r = 0; r < 16; ++r) { p0[r] = 0.f; p1[r] = 0.f; }
#pragma unroll
                for (int s = 0; s < 4; ++s) {
                    const bf16x8 k0 = *(const LAS bf16x8*)(kb + koff[s]), k1 = *(const LAS bf16x8*)(kb + koff[s] + 4096);
                    p0 = __builtin_amdgcn_mfma_f32_32x32x16_bf16(k0, qf[s], p0, 0, 0, 0);
                    p1 = __builtin_amdgcn_mfma_f32_32x32x16_bf16(k1, qf[s], p1, 0, 0, 0);
                }
                const bool need_mask = (kbase + 63 >= qmin);
                float lf0[16], lf1[16];
#pragma unroll
                for (int r = 0; r < 16; ++r) {
                    const int key0 = kbase + (r & 3) + 8 * (r >> 2) + 4 * hi;
                    { const float z = p0[r] * 0.125f; const float e = __builtin_amdgcn_exp2f(-fabsf(z) * LOG2E); const float sp = fmaxf(z, 0.f) + __builtin_amdgcn_logf(1.0f + e) * LN2;
                      float lfv = -sp, lsg = z - sp; if (need_mask && key0 >= qpos) { lfv = 0.f; lsg = NEG_INF; } lf0[r] = lfv; p0[r] = lsg; }
                    { const float z = p1[r] * 0.125f; const float e = __builtin_amdgcn_exp2f(-fabsf(z) * LOG2E); const float sp = fmaxf(z, 0.f) + __builtin_amdgcn_logf(1.0f + e) * LN2;
                      float lfv = -sp, lsg = z - sp; if (need_mask && key0 + 32 >= qpos) { lfv = 0.f; lsg = NEG_INF; } lf1[r] = lfv; p1[r] = lsg; }
                }
                float qs[8], ps[8];
#pragma unroll
                for (int g4 = 0; g4 < 4; ++g4) { qs[g4] = (lf0[4 * g4] + lf0[4 * g4 + 1]) + (lf0[4 * g4 + 2] + lf0[4 * g4 + 3]); qs[4 + g4] = (lf1[4 * g4] + lf1[4 * g4 + 1]) + (lf1[4 * g4 + 2] + lf1[4 * g4 + 3]); }
#pragma unroll
                for (int k = 0; k < 8; ++k) ps[k] = __shfl_xor(qs[k], 32);
                float run = 0.f;
#pragma unroll
                for (int k = 7; k >= 0; --k) {
                    const float base = R + run + (hi == 0 ? ps[k] : 0.f);
                    run += qs[k] + ps[k];
                    const int g4 = k & 3;
                    if (k < 4) {
                        const float a3 = base, a2 = a3 + lf0[4 * g4 + 3], a1 = a2 + lf0[4 * g4 + 2], a0 = a1 + lf0[4 * g4 + 1];
                        p0[4 * g4 + 3] = __builtin_amdgcn_exp2f((p0[4 * g4 + 3] + a3) * LOG2E); p0[4 * g4 + 2] = __builtin_amdgcn_exp2f((p0[4 * g4 + 2] + a2) * LOG2E);
                        p0[4 * g4 + 1] = __builtin_amdgcn_exp2f((p0[4 * g4 + 1] + a1) * LOG2E); p0[4 * g4 + 0] = __builtin_amdgcn_exp2f((p0[4 * g4 + 0] + a0) * LOG2E);
                    } else {
                        const float a3 = base, a2 = a3 + lf1[4 * g4 + 3], a1 = a2 + lf1[4 * g4 + 2], a0 = a1 + lf1[4 * g4 + 1];
                        p1[4 * g4 + 3] = __builtin_amdgcn_exp2f((p1[4 * g4 + 3] + a3) * LOG2E); p1[4 * g4 + 2] = __builtin_amdgcn_exp2f((p1[4 * g4 + 2] + a2) * LOG2E);
                        p1[4 * g4 + 1] = __builtin_amdgcn_exp2f((p1[4 * g4 + 1] + a1) * LOG2E); p1[4 * g4 + 0] = __builtin_amdgcn_exp2f((p1[4 * g4 + 0] + a0) * LOG2E);
                    }
                }
                R += run;
                bf16x8 pb[4];
#pragma unroll
                for (int s = 0; s < 2; ++s) {
                    u32x4 w0, w1;
                    w0.x = pg8::cvt_pk_bf16(p0[8 * s + 0], p0[8 * s + 1]); w0.y = pg8::cvt_pk_bf16(p0[8 * s + 2], p0[8 * s + 3]); w0.z = pg8::cvt_pk_bf16(p0[8 * s + 4], p0[8 * s + 5]); w0.w = pg8::cvt_pk_bf16(p0[8 * s + 6], p0[8 * s + 7]);
                    w1.x = pg8::cvt_pk_bf16(p1[8 * s + 0], p1[8 * s + 1]); w1.y = pg8::cvt_pk_bf16(p1[8 * s + 2], p1[8 * s + 3]); w1.z = pg8::cvt_pk_bf16(p1[8 * s + 4], p1[8 * s + 5]); w1.w = pg8::cvt_pk_bf16(p1[8 * s + 6], p1[8 * s + 7]);
                    pb[s] = __builtin_bit_cast(bf16x8, w0); pb[2 + s] = __builtin_bit_cast(bf16x8, w1);
                }
#pragma unroll
                for (int dblk = 0; dblk < 2; ++dblk)
#pragma unroll
                    for (int ss = 0; ss < 4; ++ss) {
                        const unsigned ad = vbase + ss * 2048 + ((dblk ^ tb) << 6);
                        const v4i16_t lo = __builtin_amdgcn_ds_read_tr16_b64_v4i16((LAS v4i16_t*)(kb + ad));
                        const v4i16_t hi4 = __builtin_amdgcn_ds_read_tr16_b64_v4i16((LAS v4i16_t*)(kb + ad + 1024));
                        bf16x8 vf; vf[0] = lo[0]; vf[1] = lo[1]; vf[2] = lo[2]; vf[3] = lo[3]; vf[4] = hi4[0]; vf[5] = hi4[1]; vf[6] = hi4[2]; vf[7] = hi4[3];
                        if (dblk == 0) o0 = __builtin_amdgcn_mfma_f32_32x32x16_bf16(vf, pb[ss], o0, 0, 0, 0);
                        else o1 = __builtin_amdgcn_mfma_f32_32x32x16_bf16(vf, pb[ss], o1, 0, 0, 0);
                    }
                wdone = __all(R < -100.0f);
            }
            if (j > 0) { *(LAS u32x4*)(lds + (buf ^ 1) * 16384 + kst) = kreg; *(LAS u32x4*)(lds + (buf ^ 1) * 16384 + vst) = vreg; }
            const int alld = __syncthreads_and(wdone ? 1 : 0);
            buf ^= 1;
            if (alld) break;
        }
        bf16_t* op = YATT + (rowbase + qpos) * 512 + h * 64 + 4 * hi;
#pragma unroll
        for (int g4 = 0; g4 < 4; ++g4) {
            u32x2 w0, w1;
            w0.x = pg8::cvt_pk_bf16(o0[4 * g4], o0[4 * g4 + 1]); w0.y = pg8::cvt_pk_bf16(o0[4 * g4 + 2], o0[4 * g4 + 3]);
            w1.x = pg8::cvt_pk_bf16(o1[4 * g4], o1[4 * g4 + 1]); w1.y = pg8::cvt_pk_bf16(o1[4 * g4 + 2], o1[4 * g4 + 3]);
            *(u32x2*)(op + 8 * g4) = w0; *(u32x2*)(op + 32 + 8 * g4) = w1;
        }
    }
}

__device__ __forceinline__ void final_phase(const Args& a) {
    const int tid = threadIdx.x, lane = tid & 63, wave = tid >> 6;
    const int gw = blockIdx.x * 8 + wave, NGW = gridDim.x * 8;
    const float* rs2 = (const float*)(a.ws + WS_CTL) + M; const float* gf = a.in[I_NFIN];
    f32x4 gv[4];
#pragma unroll
    for (int j = 0; j < 4; ++j) gv[j] = *((const f32x4*)gf + 64 * j + lane);
    for (int m = gw; m < M; m += NGW) {
        f32x4* xr = (f32x4*)(a.out + (size_t)m * DM) + lane;
        const float rstd = 1.0f / sqrtf(rs2[m] * (1.0f / DM) + EPSN);
#pragma unroll
        for (int j = 0; j < 4; ++j) { f32x4 v = xr[64 * j]; v = v * rstd * gv[j]; xr[64 * j] = v; }
    }
}

__global__ void __launch_bounds__(512, 2) fwd_megakernel(Args a) {
    extern __shared__ __attribute__((aligned(16))) unsigned char lds_raw[];
    LAS unsigned char* lds = (LAS unsigned char*)lds_raw;
    cg::grid_group grid = cg::this_grid();
    const int G = gridDim.x, c = blockIdx.x;
    unsigned char* ws = a.ws;
    bf16_t* USX = (bf16_t*)(ws + WS_USX); bf16_t* QKV = (bf16_t*)(ws + WS_QKV); bf16_t* GATES = (bf16_t*)(ws + WS_GATES);
    bf16_t* Y1 = (bf16_t*)(ws + WS_Y1); bf16_t* Y2 = (bf16_t*)(ws + WS_Y2); bf16_t* YATT = (bf16_t*)(ws + WS_YATT);
    bf16_t* T1 = (bf16_t*)(ws + WS_XN); bf16_t* HN = (bf16_t*)(ws + WS_QKV); bf16_t* HID = (bf16_t*)(ws + WS_HID);
    float* rs1 = (float*)(ws + WS_CTL); float* rs2 = rs1 + M;
    prologue(lds, a);
    grid.sync();
    { pg8::Gemm g{(const bf16_t*)(ws + WS_XN), (const bf16_t*)(ws + WS_WCAT), 1024, 1024}; pg8::StaticOrder S; S.init(M, 4096, G, c);
      pg8::EpiProj E{USX, QKV, GATES, a.in[I_BGATE]};
      pg8::gemm_phase<pg8::EpiProj, pg8::StaticOrder, true, true>(lds, g, S, E); }
    grid.sync();
    { pg8::Gemm g{USX, (const bf16_t*)(ws + WS_HH), KX, 512}; pg8::GroupOrder S{128, G, c, 0};
      pg8::EpiState E{(float*)(ws + WS_S)};
      pg8::gemm_phase<pg8::EpiState, pg8::GroupOrder, true, true>(lds, g, S, E); }
    grid.sync();
    scan_phase(lds, a);
    attn_phase(lds, a);
    grid.sync();
    { pg8::Gemm g{USX, (const bf16_t*)(ws + WS_TG), KX, KX}; pg8::GroupOrder S{256, G, c, 1};
      pg8::EpiSsmY E{Y1};
      pg8::gemm_phase<pg8::EpiSsmY, pg8::GroupOrder, true, true>(lds, g, S, E); }
    grid.sync();
    { pg8::Gemm g{Y1, (const bf16_t*)(ws + WS_WGLU), 512, 512}; pg8::StaticOrder S; S.init(M, 512, G, c);
      pg8::EpiGlu E{Y1, Y2, a.in[I_BGLU]};
      pg8::gemm_phase<pg8::EpiGlu, pg8::StaticOrder, true, true>(lds, g, S, E); }
    grid.sync();
    { pg8::Gemm g{Y2, (const bf16_t*)(ws + WS_WUPS), 512, 512}; pg8::StaticOrder S; S.init(M, 1024, G, c);
      pg8::EpiUp<false> E{GATES, T1, 0};
      pg8::gemm_phase<pg8::EpiUp<false>, pg8::StaticOrder, true, true>(lds, g, S, E); }
    { pg8::Gemm g{YATT, (const bf16_t*)(ws + WS_WUPA), 512, 512}; pg8::StaticOrder S; S.init(M, 1024, G, c);
      pg8::EpiUp<true> E{GATES, T1, 1024};
      pg8::gemm_phase<pg8::EpiUp<true>, pg8::StaticOrder, true, true>(lds, g, S, E); }
    grid.sync();
    { pg8::Gemm g{T1, (const bf16_t*)(ws + WS_WOUT), 1024, 1024}; pg8::StaticOrder S; S.init(M, 1024, G, c);
      pg8::EpiOut E{a.in[I_X], a.out, HN, a.in[I_NMLP], rs1};
      pg8::gemm_phase<pg8::EpiOut, pg8::StaticOrder, true, true>(lds, g, S, E); }
    grid.sync();
    { pg8::Gemm g{HN, (const bf16_t*)(ws + WS_W1), 1024, 1024}; pg8::StaticOrder S; S.init(M, 4096, G, c);
      pg8::EpiFf1 E{rs1, HID};
      pg8::gemm_phase<pg8::EpiFf1, pg8::StaticOrder, true, true>(lds, g, S, E); }
    grid.sync();
    { pg8::Gemm g{HID, (const bf16_t*)(ws + WS_W2), 4096, 4096}; pg8::StaticOrder S; S.init(M, 1024, G, c);
      pg8::EpiFf2 E{a.out, rs2};
      pg8::gemm_phase<pg8::EpiFf2, pg8::StaticOrder, true, true>(lds, g, S, E); }
    grid.sync();
    final_phase(a);
}

extern "C" void kernel_launch(void* const* d_in, const int* in_sizes, int n_in, void* d_out, int out_size, void* d_ws, size_t ws_size, hipStream_t stream) {
    static int grid = 0;
    if (grid == 0) {
        if (n_in != 22 || in_sizes[0] != M * DM || out_size != M * DM || ws_size < WS_END) { fprintf(stderr, "kernel_launch: unexpected shapes (n_in %d, in0 %d, out %d, ws %zu); nothing launched\n", n_in, n_in > 0 ? in_sizes[0] : -1, out_size, ws_size); grid = -1; return; }
        int dev = 0, cus = 0, per_cu = 0;
        (void)hipGetDevice(&dev);
        (void)hipDeviceGetAttribute(&cus, hipDeviceAttributeMultiprocessorCount, dev);
        (void)hipFuncSetAttribute((const void*)fwd_megakernel, hipFuncAttributeMaxDynamicSharedMemorySize, LDS_BYTES);
        (void)hipOccupancyMaxActiveBlocksPerMultiprocessor(&per_cu, (const void*)fwd_megakernel, 512, LDS_BYTES);
        if (per_cu < 1) per_cu = 1;
        grid = cus * per_cu;
        fprintf(stderr, "kernel_launch: grid %d (cus %d x %d)\n", grid, cus, per_cu);
    }
    if (grid < 0) return;
    Args a{};
    for (int i = 0; i < 22; ++i) a.in[i] = (const float*)d_in[i];
    a.out = (float*)d_out; a.ws = (unsigned char*)d_ws;
    void* args[] = {&a};
    hipError_t e = hipLaunchCooperativeKernel((const void*)fwd_megakernel, dim3(grid), dim3(512), args, LDS_BYTES, stream);
    if (e != hipSuccess) fprintf(stderr, "cooperative launch failed: %s (grid %d)\n", hipGetErrorString(e), grid);
}
```

```cpp
#include <hip/hip_runtime.h>
#include <hip/hip_cooperative_groups.h>
#include <cstdio>
#include <cstdint>
namespace cg = cooperative_groups;

namespace pg8 {
#define PG8_LAS __attribute__((address_space(3)))
typedef unsigned short bf16_t;
typedef short bf16x8 __attribute__((ext_vector_type(8)));
typedef float f32x4 __attribute__((ext_vector_type(4)));
typedef float f32x16 __attribute__((ext_vector_type(16)));
typedef unsigned u32x4 __attribute__((ext_vector_type(4)));
typedef unsigned u32x2 __attribute__((ext_vector_type(2)));
constexpr int BM = 256, BK = 64, HALF = 128, HTB = HALF * BK * 2, STAGE_BYTES = 8 * HTB, NXCD = 8, WGM = 8;
__host__ __device__ __forceinline__ int lds_byte(int r, int c) { const int st = (r >> 4) * 2 + (c >> 5), rr = r & 15, cc = c & 31, ob = rr * 64 + cc * 2; return st * 1024 + (ob ^ (((ob >> 9) & 1) << 5)); }
__host__ __device__ __forceinline__ void stage_rc(int b, int& R, int& C) { const int st = b / 1024, sb = b % 1024, swz = sb ^ (((sb >> 9) & 1) << 5); R = (st >> 1) * 16 + swz / 64; C = (st & 1) * 32 + (swz % 64) / 2; }
__host__ __device__ __forceinline__ int perm32(int rho) { const int n = rho >> 4, i = rho & 15; return 8 * (i >> 2) + 4 * n + (i & 3); }
struct Unit { int pm, pn; };
struct Gemm { const bf16_t* A; const bf16_t* Bt; int lda, K; };
struct StaticOrder {
    int nM, nN, nwg, G, c;
    __host__ __device__ void init(int M, int N, int G_, int c_) { nM = M / BM; nN = N / BM; nwg = nM * nN; G = G_; c = c_; }
    __host__ __device__ bool next(int i, Unit& u) const {
        const long L = (long)i * G + c; if (L >= nwg) return false;
        int wgid = (int)L; { const int q = nwg / NXCD, r = nwg % NXCD, xcd = wgid % NXCD, off = wgid / NXCD; wgid = (xcd < r ? xcd * (q + 1) : r * (q + 1) + (xcd - r) * q) + off; }
        const int nig = WGM * nN, gid = wgid / nig, fm = gid * WGM, gsz = (nM - fm) < WGM ? (nM - fm) : WGM;
        u.pm = fm + ((wgid % nig) % gsz); u.pn = (wgid % nig) / gsz; return true;
    }
    __device__ __forceinline__ void a_ready(const Unit&) const {}
    __device__ __forceinline__ void done(const Unit&) const {}
};
struct GroupOrder {
    int nunits, G, c, mode;
    __host__ __device__ bool next(int i, Unit& u) const {
        const int L = i * G + c; if (L >= nunits) return false;
        if (mode == 0) { u.pm = L; u.pn = L >> 2; } else { const int g = L >> 3; u.pm = 4 * g + (L & 3); u.pn = 2 * g + ((L >> 2) & 1); }
        return true;
    }
    __device__ __forceinline__ void a_ready(const Unit&) const {}
    __device__ __forceinline__ void done(const Unit&) const {}
};
__device__ __forceinline__ unsigned cvt_pk_bf16(float lo, float hi) { unsigned r; asm volatile("v_cvt_pk_bf16_f32 %0, %1, %2" : "=v"(r) : "v"(lo), "v"(hi)); return r; }
__device__ __forceinline__ u32x4 pack8(f32x4 a, f32x4 b) { u32x4 w; w.x = cvt_pk_bf16(a[0], a[1]); w.y = cvt_pk_bf16(a[2], a[3]); w.z = cvt_pk_bf16(b[0], b[1]); w.w = cvt_pk_bf16(b[2], b[3]); return w; }
__device__ __forceinline__ void unpack8(u32x4 w, f32x4& a, f32x4& b) {
    a[0] = __uint_as_float(w.x << 16); a[1] = __uint_as_float(w.x & 0xffff0000u); a[2] = __uint_as_float(w.y << 16); a[3] = __uint_as_float(w.y & 0xffff0000u);
    b[0] = __uint_as_float(w.z << 16); b[1] = __uint_as_float(w.z & 0xffff0000u); b[2] = __uint_as_float(w.w << 16); b[3] = __uint_as_float(w.w & 0xffff0000u);
}
__device__ __forceinline__ float sigmoidf_(float x) { return __builtin_amdgcn_rcpf(1.0f + __builtin_amdgcn_exp2f(-1.4426950408889634f * x)); }
__device__ __forceinline__ f32x4 sigmoid4(f32x4 v) { f32x4 o; o[0] = sigmoidf_(v[0]); o[1] = sigmoidf_(v[1]); o[2] = sigmoidf_(v[2]); o[3] = sigmoidf_(v[3]); return o; }

#define EPI_ARGS const f32x4 (&acc)[2][2][4][2], const Unit& u, int wr, int wc, int fr, int fq
#define EPI_LOOP_BEGIN \
    _Pragma("unroll") for (int ai = 0; ai < 2; ++ai) _Pragma("unroll") for (int m = 0; m < 4; ++m) { const int row = u.pm * 256 + ai * 128 + wr * 64 + m * 16 + fr; \
    _Pragma("unroll") for (int bj = 0; bj < 2; ++bj) { const int col = u.pn * 256 + bj * 128 + wc * 32 + 8 * fq; f32x4 v0 = acc[ai][bj][m][0], v1 = acc[ai][bj][m][1];
#define EPI_LOOP_END } }

struct EpiProj {
    static constexpr bool PERM = true, AFTER_DRAIN = false;
    bf16_t* usx; bf16_t* qkv; bf16_t* gates; const float* bgate;
    __device__ __forceinline__ void operator()(EPI_ARGS) const {
        const int colt = u.pn * 256;
        if (colt < 512) {
            EPI_LOOP_BEGIN
                const int g = col >> 4, ci0 = col & 15, chunk = row >> 5, t = row & 31;
                *(u32x4*)(usx + ((size_t)(g * 1024 + chunk)) * 640 + t * 16 + ci0) = pack8(v0, v1);
            EPI_LOOP_END
        } else if (colt < 2048) {
            EPI_LOOP_BEGIN
                *(u32x4*)(qkv + (size_t)row * 1536 + (col - 512)) = pack8(v0, v1);
            EPI_LOOP_END
        } else {
            EPI_LOOP_BEGIN
                const int c2 = col - 2048;
                const f32x4 b0 = *(const f32x4*)(bgate + c2), b1 = *(const f32x4*)(bgate + c2 + 4);
                *(u32x4*)(gates + (size_t)row * 2048 + c2) = pack8(sigmoid4(v0 + b0), sigmoid4(v1 + b1));
            EPI_LOOP_END
        }
    }
};
struct EpiState {
    static constexpr bool PERM = true, AFTER_DRAIN = false;
    float* S;
    __device__ __forceinline__ void operator()(EPI_ARGS) const {
        EPI_LOOP_BEGIN
            if (bj == 0) { const int cl = wc * 32 + 8 * fq; float* d = S + (size_t)row * 128 + cl; *(f32x4*)d = v0; *(f32x4*)(d + 4) = v1; }
            (void)col;
        EPI_LOOP_END
    }
};
__device__ __forceinline__ float gelu_tanh_(float x) { const float u = 0.7978845608028654f * (x + 0.044715f * x * x * x); return x * sigmoidf_(2.0f * u); }
struct EpiSsmY {
    static constexpr bool PERM = true, AFTER_DRAIN = false;
    bf16_t* Y1;
    __device__ __forceinline__ void operator()(EPI_ARGS) const {
        EPI_LOOP_BEGIN
            const int g = row >> 10, chunkg = row & 1023, cl = (col & 511), t = cl >> 4, co0 = cl & 15;
            f32x4 a, b;
#pragma unroll
            for (int e = 0; e < 4; ++e) { a[e] = gelu_tanh_(v0[e]); b[e] = gelu_tanh_(v1[e]); }
            *(u32x4*)(Y1 + (size_t)(chunkg * 32 + t) * 512 + g * 16 + co0) = pack8(a, b);
        EPI_LOOP_END
    }
};
struct EpiGlu {
    static constexpr bool PERM = true, AFTER_DRAIN = false;
    const bf16_t* Y1; bf16_t* Y2; const float* bglu;
    __device__ __forceinline__ void operator()(EPI_ARGS) const {
        EPI_LOOP_BEGIN
            const f32x4 b0 = *(const f32x4*)(bglu + col), b1 = *(const f32x4*)(bglu + col + 4);
            f32x4 y0, y1; unpack8(*(const u32x4*)(Y1 + (size_t)row * 512 + col), y0, y1);
            *(u32x4*)(Y2 + (size_t)row * 512 + col) = pack8(y0 * sigmoid4(v0 + b0), y1 * sigmoid4(v1 + b1));
        EPI_LOOP_END
    }
};
template <bool ADD> struct EpiUp {
    static constexpr bool PERM = true, AFTER_DRAIN = false;
    const bf16_t* gates; bf16_t* T1; int goff;
    __device__ __forceinline__ void operator()(EPI_ARGS) const {
        EPI_LOOP_BEGIN
            f32x4 g0, g1; unpack8(*(const u32x4*)(gates + (size_t)row * 2048 + goff + col), g0, g1);
            f32x4 r0 = g0 * v0, r1 = g1 * v1;
            bf16_t* d = T1 + (size_t)row * 1024 + col;
            if (ADD) { f32x4 t0, t1; unpack8(*(const u32x4*)d, t0, t1); r0 += t0; r1 += t1; }
            *(u32x4*)d = pack8(r0, r1);
        EPI_LOOP_END
    }
};
struct EpiOut {
    static constexpr bool PERM = true, AFTER_DRAIN = false;
    const float* x; float* hout; bf16_t* HN; const float* gn; float* rowss;
    __device__ __forceinline__ void operator()(EPI_ARGS) const {
#pragma unroll
        for (int ai = 0; ai < 2; ++ai)
#pragma unroll
            for (int m = 0; m < 4; ++m) {
                const int row = u.pm * 256 + ai * 128 + wr * 64 + m * 16 + fr; float ss = 0.f;
#pragma unroll
                for (int bj = 0; bj < 2; ++bj) {
                    const int col = u.pn * 256 + bj * 128 + wc * 32 + 8 * fq; const size_t o = (size_t)row * 1024 + col;
                    const f32x4 h0 = *(const f32x4*)(x + o) + acc[ai][bj][m][0], h1 = *(const f32x4*)(x + o + 4) + acc[ai][bj][m][1];
                    *(f32x4*)(hout + o) = h0; *(f32x4*)(hout + o + 4) = h1;
                    const f32x4 n0 = *(const f32x4*)(gn + col), n1 = *(const f32x4*)(gn + col + 4);
                    *(u32x4*)(HN + o) = pack8(h0 * n0, h1 * n1);
                    const f32x4 q0 = h0 * h0, q1 = h1 * h1; ss += (q0[0] + q0[1]) + (q0[2] + q0[3]) + (q1[0] + q1[1]) + (q1[2] + q1[3]);
                }
                ss += __shfl_xor(ss, 16); ss += __shfl_xor(ss, 32);
                if (fq == 0) atomicAdd(rowss + row, ss);
            }
    }
};
struct EpiFf1 {
    static constexpr bool PERM = true, AFTER_DRAIN = false;
    const float* rowss; bf16_t* HID;
    __device__ __forceinline__ void operator()(EPI_ARGS) const {
#pragma unroll
        for (int ai = 0; ai < 2; ++ai)
#pragma unroll
            for (int m = 0; m < 4; ++m) {
                const int row = u.pm * 256 + ai * 128 + wr * 64 + m * 16 + fr;
                const float r2 = 1.0f / (rowss[row] * (1.0f / 1024.0f) + 1e-6f);
#pragma unroll
                for (int bj = 0; bj < 2; ++bj) {
                    const int col = u.pn * 256 + bj * 128 + wc * 32 + 8 * fq;
                    f32x4 a = acc[ai][bj][m][0], b = acc[ai][bj][m][1];
#pragma unroll
                    for (int e = 0; e < 4; ++e) { const float p = fmaxf(a[e], 0.f), q = fmaxf(b[e], 0.f); a[e] = p * p * r2; b[e] = q * q * r2; }
                    *(u32x4*)(HID + (size_t)row * 4096 + col) = pack8(a, b);
                }
            }
    }
};
struct EpiFf2 {
    static constexpr bool PERM = true, AFTER_DRAIN = false;
    float* h; float* rowss;
    __device__ __forceinline__ void operator()(EPI_ARGS) const {
#pragma unroll
        for (int ai = 0; ai < 2; ++ai)
#pragma unroll
            for (int m = 0; m < 4; ++m) {
                const int row = u.pm * 256 + ai * 128 + wr * 64 + m * 16 + fr; float ss = 0.f;
#pragma unroll
                for (int bj = 0; bj < 2; ++bj) {
                    const int col = u.pn * 256 + bj * 128 + wc * 32 + 8 * fq; const size_t o = (size_t)row * 1024 + col;
                    const f32x4 h0 = *(const f32x4*)(h + o) + acc[ai][bj][m][0], h1 = *(const f32x4*)(h + o + 4) + acc[ai][bj][m][1];
                    *(f32x4*)(h + o) = h0; *(f32x4*)(h + o + 4) = h1;
                    const f32x4 q0 = h0 * h0, q1 = h1 * h1; ss += (q0[0] + q0[1]) + (q0[2] + q0[3]) + (q1[0] + q1[1]) + (q1[2] + q1[3]);
                }
                ss += __shfl_xor(ss, 16); ss += __shfl_xor(ss, 32);
                if (fq == 0) atomicAdd(rowss + row, ss);
            }
    }
};

template <class Epi, class Sched, bool ALIGN_EPI = false, bool SP2 = false>
__device__ __forceinline__ void gemm_phase(PG8_LAS unsigned char* lds, const Gemm g, const Sched& S, const Epi& E) {
    int tid_ = threadIdx.x; asm volatile("" : "+v"(tid_));
    const int tid = tid_, wid = __builtin_amdgcn_readfirstlane(tid >> 6), lane = tid & 63, wr = wid >> 2, wc = wid & 3, fr = lane & 15, fq = lane >> 4;
    const int K = g.K, nt = K / BK;
    unsigned voffA[2], voffB[2];
#pragma unroll
    for (int i = 0; i < 2; ++i) { int R, C; stage_rc(tid * 16 + i * 8192, R, C); const int Rb = Epi::PERM ? ((R & ~31) + perm32(R & 31)) : R;
        voffA[i] = (unsigned)(R * g.lda + C) * 2u; voffB[i] = (unsigned)(Rb * K + C) * 2u; }
    const size_t kstep = (size_t)(BK * 2);
    const size_t hstepA = (size_t)HALF * g.lda * 2, hstepB = (size_t)HALF * K * 2;
    const size_t tstepA = 2 * hstepA, tstepB = 2 * hstepB;
    const unsigned ldsw = (unsigned)wid * 1024u;
    const int aoff = lds_byte(wr * 64 + fr, fq * 8), boff = lds_byte(wc * 32 + fr, fq * 8);
#define PG8_SA(b, h) (((b) * 2 + (h)) * HTB)
#define PG8_SB(b, h) ((4 + (b) * 2 + (h)) * HTB)
#define PG8_STAGE(bufoff, gbase, voff) do { _Pragma("unroll") for (int _i = 0; _i < 2; ++_i) \
        __builtin_amdgcn_global_load_lds((const unsigned*)((const char*)(gbase) + (voff)[_i]), (PG8_LAS unsigned*)(lds + (bufoff) + ldsw + _i * 8192), 16, 0, 0); } while (0)
#define PG8_LDA(dst, b, h) do { _Pragma("unroll") for (int m = 0; m < 4; ++m) _Pragma("unroll") for (int k = 0; k < 2; ++k) dst[m][k] = *(const PG8_LAS bf16x8*)(lds + PG8_SA(b, h) + aoff + m * 2048 + k * 1024); } while (0)
#define PG8_LDB(dst, b, h) do { _Pragma("unroll") for (int n = 0; n < 2; ++n) _Pragma("unroll") for (int k = 0; k < 2; ++k) dst[n][k] = *(const PG8_LAS bf16x8*)(lds + PG8_SB(b, h) + boff + n * 2048 + k * 1024); } while (0)
#define PG8_MMA(ai, bj, At, Bt) do { __builtin_amdgcn_s_setprio(1); _Pragma("unroll") for (int m = 0; m < 4; ++m) _Pragma("unroll") for (int n = 0; n < 2; ++n) _Pragma("unroll") for (int k = 0; k < 2; ++k) \
        acc[ai][bj][m][n] = __builtin_amdgcn_mfma_f32_16x16x32_bf16(Bt[n][k], At[m][k], acc[ai][bj][m][n], 0, 0, 0); __builtin_amdgcn_s_setprio(0); } while (0)
#define PG8_WAIT_V(n) asm volatile("s_waitcnt vmcnt(" #n ")" ::: "memory")
#define PG8_WAIT_L(n) asm volatile("s_waitcnt lgkmcnt(" #n ")" ::: "memory")
#define PG8_BAR __builtin_amdgcn_s_barrier()
#define PG8_SCHED __builtin_amdgcn_sched_barrier(0)
    Unit cur, nxt; int ui = 0;
    if (!S.next(0, cur)) return;
    f32x4 acc[2][2][4][2];
#pragma unroll
    for (int a = 0; a < 2; ++a)
#pragma unroll
        for (int b = 0; b < 2; ++b)
#pragma unroll
            for (int m = 0; m < 4; ++m)
#pragma unroll
                for (int n = 0; n < 2; ++n) acc[a][b][m][n] = (f32x4){0.f, 0.f, 0.f, 0.f};
    bf16x8 At[4][2], B0[2][2], B1[2][2];
    const char* cA = (const char*)g.A + (size_t)cur.pm * tstepA; const char* cB = (const char*)g.Bt + (size_t)cur.pn * tstepB;
    S.a_ready(cur);
    if constexpr (SP2) {
        PG8_STAGE(PG8_SB(0, 0), cB, voffB); PG8_STAGE(PG8_SB(0, 1), cB + hstepB, voffB); PG8_STAGE(PG8_SA(0, 0), cA, voffA); PG8_STAGE(PG8_SA(0, 1), cA + hstepA, voffA);
        if (wr == 1) PG8_BAR;
        PG8_WAIT_V(2); PG8_BAR;
        PG8_STAGE(PG8_SB(1, 0), cB + kstep, voffB); PG8_STAGE(PG8_SA(1, 0), cA + kstep, voffA); PG8_STAGE(PG8_SB(1, 1), cB + hstepB + kstep, voffB);
        PG8_WAIT_V(6); PG8_BAR;
    } else {
        PG8_STAGE(PG8_SB(0, 0), cB, voffB); PG8_STAGE(PG8_SA(0, 0), cA, voffA); PG8_STAGE(PG8_SB(0, 1), cB + hstepB, voffB); PG8_STAGE(PG8_SA(0, 1), cA + hstepA, voffA);
        if (wr == 1) PG8_BAR;
        PG8_WAIT_V(4); PG8_BAR;
        PG8_STAGE(PG8_SB(1, 0), cB + kstep, voffB); PG8_STAGE(PG8_SA(1, 0), cA + kstep, voffA); PG8_STAGE(PG8_SB(1, 1), cB + hstepB + kstep, voffB);
        PG8_WAIT_V(6); PG8_BAR;
    }
    for (;;) {
        const bool has_next = S.next(ui + 1, nxt);
        const char* nA = has_next ? (const char*)g.A + (size_t)nxt.pm * tstepA : cA; const char* nB = has_next ? (const char*)g.Bt + (size_t)nxt.pn * tstepB : cB;
        for (int t = 0; t < nt; t += 2) {
            const bool last = (t == nt - 2);
            const char* a1 = cA + (size_t)(t + 1) * kstep;
            const char* a2 = last ? nA : cA + (size_t)(t + 2) * kstep; const char* b2 = last ? nB : cB + (size_t)(t + 2) * kstep;
            const char* a3 = a2 + kstep; const char* b3 = b2 + kstep;
            if (last && has_next) S.a_ready(nxt);
            if constexpr (SP2) {
            PG8_LDB(B0, 0, 0); PG8_LDB(B1, 0, 1); PG8_SCHED; PG8_LDA(At, 0, 0); PG8_STAGE(PG8_SA(1, 1), a1 + hstepA, voffA);
            PG8_WAIT_V(8); PG8_WAIT_L(0); PG8_BAR; PG8_MMA(0, 0, At, B0); PG8_MMA(0, 1, At, B1); PG8_BAR; PG8_SCHED;
            PG8_LDA(At, 0, 1); PG8_STAGE(PG8_SB(0, 0), b2, voffB); PG8_STAGE(PG8_SB(0, 1), b2 + hstepB, voffB); PG8_STAGE(PG8_SA(0, 0), a2, voffA);
            PG8_WAIT_V(8); PG8_WAIT_L(0); PG8_BAR; PG8_MMA(1, 0, At, B0); PG8_MMA(1, 1, At, B1); PG8_BAR; PG8_SCHED;
            PG8_LDB(B0, 1, 0); PG8_LDB(B1, 1, 1); PG8_SCHED; PG8_LDA(At, 1, 0); PG8_STAGE(PG8_SA(0, 1), a2 + hstepA, voffA);
            PG8_WAIT_V(8); PG8_WAIT_L(0); PG8_BAR; PG8_MMA(0, 0, At, B0); PG8_MMA(0, 1, At, B1); PG8_BAR; PG8_SCHED;
            PG8_LDA(At, 1, 1); PG8_STAGE(PG8_SB(1, 0), b3, voffB); PG8_STAGE(PG8_SB(1, 1), b3 + hstepB, voffB); PG8_STAGE(PG8_SA(1, 0), a3, voffA);
            PG8_WAIT_V(8); PG8_WAIT_L(0); PG8_BAR; PG8_MMA(1, 0, At, B0); PG8_MMA(1, 1, At, B1); PG8_BAR; PG8_SCHED;
            } else {
            PG8_LDB(B0, 0, 0); PG8_SCHED; PG8_LDA(At, 0, 0); PG8_STAGE(PG8_SA(1, 1), a1 + hstepA, voffA);
            PG8_WAIT_L(8); PG8_BAR; PG8_WAIT_L(0); PG8_MMA(0, 0, At, B0); PG8_BAR; PG8_SCHED;
            PG8_LDB(B1, 0, 1); PG8_STAGE(PG8_SB(0, 0), b2, voffB);
            PG8_BAR; PG8_WAIT_L(0); PG8_MMA(0, 1, At, B1); PG8_BAR;
            PG8_LDA(At, 0, 1); PG8_STAGE(PG8_SA(0, 0), a2, voffA);
            PG8_BAR; PG8_WAIT_L(0); PG8_MMA(1, 0, At, B0); PG8_BAR; PG8_SCHED;
            PG8_STAGE(PG8_SB(0, 1), b2 + hstepB, voffB);
            PG8_WAIT_V(6); PG8_BAR; PG8_MMA(1, 1, At, B1); PG8_BAR;
            PG8_LDB(B0, 1, 0); PG8_SCHED; PG8_LDA(At, 1, 0); PG8_STAGE(PG8_SA(0, 1), a2 + hstepA, voffA);
            PG8_WAIT_L(8); PG8_BAR; PG8_WAIT_L(0); PG8_MMA(0, 0, At, B0); PG8_BAR; PG8_SCHED;
            PG8_LDB(B1, 1, 1); PG8_STAGE(PG8_SB(1, 0), b3, voffB);
            PG8_BAR; PG8_WAIT_L(0); PG8_MMA(0, 1, At, B1); PG8_BAR;
            PG8_LDA(At, 1, 1); PG8_STAGE(PG8_SA(1, 0), a3, voffA);
            PG8_BAR; PG8_WAIT_L(0); PG8_MMA(1, 0, At, B0); PG8_BAR; PG8_SCHED;
            PG8_STAGE(PG8_SB(1, 1), b3 + hstepB, voffB);
            PG8_WAIT_V(6); PG8_BAR; PG8_MMA(1, 1, At, B1); PG8_BAR;
            }
        }
        if constexpr (ALIGN_EPI) { if (wr == 0) PG8_BAR; }
        if constexpr (!Epi::AFTER_DRAIN) { E(acc, cur, wr, wc, fr, fq); S.done(cur); }
        if (!has_next) break;
#pragma unroll
        for (int a = 0; a < 2; ++a)
#pragma unroll
            for (int b = 0; b < 2; ++b)
#pragma unroll
                for (int m = 0; m < 4; ++m)
#pragma unroll
                    for (int n = 0; n < 2; ++n) acc[a][b][m][n] = (f32x4){0.f, 0.f, 0.f, 0.f};
        cur = nxt; cA = nA; cB = nB; ++ui;
        if constexpr (ALIGN_EPI) { if (wr == 1) PG8_BAR; }
    }
    PG8_WAIT_V(0);
    if constexpr (!ALIGN_EPI) { if (wr == 0) PG8_BAR; }
    PG8_BAR;
    if constexpr (Epi::AFTER_DRAIN) { E.fused(acc, cur, wr, wc, fr, fq, lds, wid, lane); S.done(cur); }
#undef PG8_SA
#undef PG8_SB
#undef PG8_STAGE
#undef PG8_LDA
#undef PG8_LDB
#undef PG8_MMA
#undef PG8_WAIT_V
#undef PG8_WAIT_L
#undef PG8_BAR
#undef PG8_SCHED
}
}

using pg8::bf16_t; using pg8::bf16x8; using pg8::f32x4; using pg8::f32x16; using pg8::u32x4; using pg8::u32x2;
#define LAS __attribute__((address_space(3)))
typedef short v4i16_t __attribute__((ext_vector_type(4)));

constexpr int DM = 1024, NBATCH = 4, SEQ = 8192, M = NBATCH * SEQ, DSSM = 512, NG = 32, NST = 64, NHEAD = 8, DFF = 4096;
constexpr int LCH = 32, NCHG = M / LCH  , KX = 640;
constexpr float EPSN = 1e-6f;
constexpr size_t MiB = 1u << 20;
constexpr size_t WS_CTL = 0;
constexpr size_t WS_WCAT = 1 * MiB, WS_WGLU = 9 * MiB, WS_WUPS = 10 * MiB, WS_WUPA = 11 * MiB, WS_WOUT = 12 * MiB, WS_W1 = 14 * MiB, WS_W2 = 22 * MiB;
constexpr size_t WS_TG = 32 * MiB, WS_HH = 52 * MiB, WS_APOW = 60 * MiB, WS_S = 64 * MiB, WS_USX = 84 * MiB;
constexpr size_t WS_XN = 128 * MiB;
constexpr size_t WS_QKV = 192 * MiB;
constexpr size_t WS_GATES = 288 * MiB, WS_Y1 = 416 * MiB, WS_Y2 = 448 * MiB, WS_YATT = 480 * MiB;
constexpr size_t WS_HID = 256 * MiB, WS_END = 512 * MiB;
constexpr int LDS_BYTES = 147456;

__device__ __forceinline__ unsigned f2bf(float f) { unsigned u = __builtin_bit_cast(unsigned, f); return (u + 0x7fffu + ((u >> 16) & 1u)) >> 16; }
__device__ __forceinline__ unsigned pk2(float lo, float hi) { return f2bf(lo) | (f2bf(hi) << 16); }
__device__ __forceinline__ float wave_sum(float v) {
#pragma unroll
    for (int o = 1; o < 64; o <<= 1) v += __shfl_xor(v, o);
    return v;
}
__device__ __forceinline__ void transpose_item(const float* __restrict__ W, int K, int N, bf16_t* __restrict__ WT, int row_off, LAS float* scr, int item, int lane) {
    const int nblk = N / 32, kb = item / nblk, nb = item % nblk, k0 = 64 * kb, n0 = 32 * nb;
#pragma unroll 8
    for (int i = 0; i < 32; ++i) { const int kk = 2 * i + (lane >> 5); scr[kk * 33 + (lane & 31)] = W[(size_t)(k0 + kk) * N + n0 + (lane & 31)]; }
    asm volatile("s_waitcnt lgkmcnt(0)" ::: "memory");
    const int c = lane & 7;
#pragma unroll
    for (int j = 0; j < 4; ++j) { const int n = (lane >> 3) + 8 * j; const LAS float* s = scr + (8 * c) * 33 + n;
        u32x4 o; o.x = pk2(s[0 * 33], s[1 * 33]); o.y = pk2(s[2 * 33], s[3 * 33]); o.z = pk2(s[4 * 33], s[5 * 33]); o.w = pk2(s[6 * 33], s[7 * 33]);
        *(u32x4*)(WT + (size_t)(row_off + n0 + n) * K + k0 + 8 * c) = o; }
    asm volatile("s_waitcnt lgkmcnt(0)" ::: "memory");
}

struct Args { const float* in[22]; float* out; unsigned char* ws; };
enum { I_X = 0, I_NMIX, I_WIN, I_ARE, I_AIM, I_LOGDT, I_BRE, I_BIM, I_CRE, I_CIM, I_DSKIP, I_WGLU, I_BGLU, I_WUPS, I_WUPA, I_WGATE, I_BGATE, I_WOUT, I_NMLP, I_W1, I_W2, I_NFIN };

__device__ __forceinline__ void ssm_precompute_item(LAS unsigned char* lds, const Args& a, int item) {
    const int g = item >> 3, part = item & 7, tid = threadIdx.x;
    LAS float* E = (LAS float*)lds;
    LAS float* BB = E + 33 * 64 * 2;
    LAS float* CC = BB + 64 * 16 * 2;
    LAS float* KT = CC + 16 * 64 * 2;
    const float* A_re = a.in[I_ARE] + g * 64; const float* A_im = a.in[I_AIM] + g * 64;
    const float dt = expf(a.in[I_LOGDT][g]);
    for (int idx = tid; idx < 33 * 64; idx += 512) { const int n = idx >> 6, p = idx & 63; const float ar = A_re[p] * dt, ai = A_im[p] * dt;
        const float mag = expf(ar * (float)n), th = ai * (float)n; E[idx * 2] = mag * cosf(th); E[idx * 2 + 1] = mag * sinf(th); }
    for (int idx = tid; idx < 64 * 16; idx += 512) { const int p = idx >> 4, ci = idx & 15; const float lr = A_re[p], li = A_im[p], ar = lr * dt, ai = li * dt;
        const float mag = expf(ar), are = mag * cosf(ai) - 1.0f, aim = mag * sinf(ai), den = 1.0f / (lr * lr + li * li);
        const float cfr = (are * lr + aim * li) * den, cfi = (aim * lr - are * li) * den;
        const float br = a.in[I_BRE][(size_t)(g * 64 + p) * 16 + ci], bi = a.in[I_BIM][(size_t)(g * 64 + p) * 16 + ci];
        BB[idx * 2] = cfr * br - cfi * bi; BB[idx * 2 + 1] = cfr * bi + cfi * br; }
    for (int idx = tid; idx < 16 * 64; idx += 512) { CC[idx * 2] = a.in[I_CRE][(size_t)g * 1024 + idx]; CC[idx * 2 + 1] = a.in[I_CIM][(size_t)g * 1024 + idx]; }
    __syncthreads();
    {
        const int tau = tid >> 4, co = tid & 15;
        if (tau <= 4 * part + 3) {
            float acc[16];
#pragma unroll
            for (int i = 0; i < 16; ++i) acc[i] = 0.f;
            for (int p = 0; p < 64; ++p) {
                const float cr = CC[(co * 64 + p) * 2], ci_ = CC[(co * 64 + p) * 2 + 1], er = E[(tau * 64 + p) * 2], ei = E[(tau * 64 + p) * 2 + 1];
                const float wr = cr * er - ci_ * ei, wi = cr * ei + ci_ * er;
#pragma unroll
                for (int i = 0; i < 16; ++i) acc[i] += wr * BB[(p * 16 + i) * 2] - wi * BB[(p * 16 + i) * 2 + 1];
            }
#pragma unroll
            for (int i = 0; i < 16; ++i) KT[(tau * 16 + co) * 16 + i] = acc[i];
        }
    }
    __syncthreads();
    bf16_t* TG = (bf16_t*)(a.ws + WS_TG); bf16_t* HH = (bf16_t*)(a.ws + WS_HH);
    for (int idx = tid; idx < 64 * 80; idx += 512) {
        const int rl = idx / 80, ch = idx - rl * 80, n = part * 64 + rl, t = n >> 4, co = n & 15;
        float v[8];
        if (ch < 64) {
            const int s = ch >> 1, ci0 = (ch & 1) * 8;
#pragma unroll
            for (int e = 0; e < 8; ++e) { float x = 0.f; if (s <= t) x = KT[((t - s) * 16 + co) * 16 + ci0 + e]; if (s == t && ci0 + e == co) x += a.in[I_DSKIP][g * 16 + co]; v[e] = x; }
        } else {
#pragma unroll
            for (int e = 0; e < 8; ++e) { const int j = (ch - 64) * 8 + e, p = j & 63; const float cr = CC[(co * 64 + p) * 2], ci_ = CC[(co * 64 + p) * 2 + 1], er = E[((t + 1) * 64 + p) * 2], ei = E[((t + 1) * 64 + p) * 2 + 1];
                v[e] = (j < 64) ? (cr * er - ci_ * ei) : -(cr * ei + ci_ * er); }
        }
        u32x4 o; o.x = pk2(v[0], v[1]); o.y = pk2(v[2], v[3]); o.z = pk2(v[4], v[5]); o.w = pk2(v[6], v[7]);
        *(u32x4*)(TG + ((size_t)(g * 512 + n)) * KX + ch * 8) = o;
    }
    for (int idx = tid; idx < 32 * 64; idx += 512) {
        const int rl = idx >> 6, ch = idx & 63, jr = part * 32 + rl, s = ch >> 1, ci0 = (ch & 1) * 8;
        float v[8];
#pragma unroll
        for (int e = 0; e < 8; ++e) { float x = 0.f;
            if (jr < 128) { const int p = jr & 63; const float er = E[((31 - s) * 64 + p) * 2], ei = E[((31 - s) * 64 + p) * 2 + 1], br = BB[(p * 16 + ci0 + e) * 2], bi = BB[(p * 16 + ci0 + e) * 2 + 1];
                x = (jr < 64) ? (er * br - ei * bi) : (er * bi + ei * br); }
            v[e] = x; }
        u32x4 o; o.x = pk2(v[0], v[1]); o.y = pk2(v[2], v[3]); o.z = pk2(v[4], v[5]); o.w = pk2(v[6], v[7]);
        *(u32x4*)(HH + ((size_t)(g * 256 + jr)) * 512 + ch * 8) = o;
    }
    if (part == 0 && tid < 64) { float* AP = (float*)(a.ws + WS_APOW); AP[(g * 64 + tid) * 2] = E[(32 * 64 + tid) * 2]; AP[(g * 64 + tid) * 2 + 1] = E[(32 * 64 + tid) * 2 + 1]; }
    __syncthreads();
}

__device__ __forceinline__ void prologue(LAS unsigned char* lds, const Args& a) {
    const int tid = threadIdx.x, lane = tid & 63, wave = tid >> 6, G = gridDim.x;
    { float* rs = (float*)(a.ws + WS_CTL); for (int i = blockIdx.x * 512 + tid; i < 2 * M; i += G * 512) rs[i] = 0.f; }
    for (int it = blockIdx.x; it < 256; it += G) ssm_precompute_item(lds, a, it);
    LAS float* scr = (LAS float*)(lds + wave * 16384);
    const int gw = blockIdx.x * 8 + wave, NGW = G * 8;
    bf16_t* WCAT = (bf16_t*)(a.ws + WS_WCAT);
    constexpr int I_IN = 16 * 64, I_GT = 16 * 64, I_GLU = 8 * 16, I_UPS = 8 * 32, I_UPA = 8 * 32, I_OUT = 16 * 32, I_F1 = 16 * 128, I_F2 = 64 * 32;
    constexpr int NITEMS = I_IN + I_GT + I_GLU + I_UPS + I_UPA + I_OUT + I_F1 + I_F2;
    for (int it = gw; it < NITEMS; it += NGW) {
        int r = it;
        if (r < I_IN) { transpose_item(a.in[I_WIN], 1024, 2048, WCAT, 0, scr, r, lane); continue; } r -= I_IN;
        if (r < I_GT) { transpose_item(a.in[I_WGATE], 1024, 2048, WCAT, 2048, scr, r, lane); continue; } r -= I_GT;
        if (r < I_GLU) { transpose_item(a.in[I_WGLU], 512, 512, (bf16_t*)(a.ws + WS_WGLU), 0, scr, r, lane); continue; } r -= I_GLU;
        if (r < I_UPS) { transpose_item(a.in[I_WUPS], 512, 1024, (bf16_t*)(a.ws + WS_WUPS), 0, scr, r, lane); continue; } r -= I_UPS;
        if (r < I_UPA) { transpose_item(a.in[I_WUPA], 512, 1024, (bf16_t*)(a.ws + WS_WUPA), 0, scr, r, lane); continue; } r -= I_UPA;
        if (r < I_OUT) { transpose_item(a.in[I_WOUT], 1024, 1024, (bf16_t*)(a.ws + WS_WOUT), 0, scr, r, lane); continue; } r -= I_OUT;
        if (r < I_F1) { transpose_item(a.in[I_W1], 1024, 4096, (bf16_t*)(a.ws + WS_W1), 0, scr, r, lane); continue; } r -= I_F1;
        transpose_item(a.in[I_W2], 4096, 1024, (bf16_t*)(a.ws + WS_W2), 0, scr, r, lane);
    }
    const float* x = a.in[I_X]; const float* gm = a.in[I_NMIX]; bf16_t* XN = (bf16_t*)(a.ws + WS_XN);
    f32x4 gv[4];
#pragma unroll
    for (int j = 0; j < 4; ++j) gv[j] = *((const f32x4*)gm + 64 * j + lane);
    for (int m = gw; m < M; m += NGW) {
        const f32x4* xr = (const f32x4*)(x + (size_t)m * DM) + lane; f32x4 v[4]; float s = 0.f;
#pragma unroll
        for (int j = 0; j < 4; ++j) { v[j] = xr[64 * j]; s += (v[j][0] * v[j][0] + v[j][1] * v[j][1]) + (v[j][2] * v[j][2] + v[j][3] * v[j][3]); }
        const float rstd = 1.0f / sqrtf(wave_sum(s) * (1.0f / DM) + EPSN);
        u32x2* o8 = (u32x2*)(XN + (size_t)m * DM) + lane;
#pragma unroll
        for (int j = 0; j < 4; ++j) { u32x2 o; o.x = pk2(v[j][0] * rstd * gv[j][0], v[j][1] * rstd * gv[j][1]); o.y = pk2(v[j][2] * rstd * gv[j][2], v[j][3] * rstd * gv[j][3]); o8[64 * j] = o; }
    }
}

__device__ __forceinline__ void scan_phase(LAS unsigned char* lds, const Args& a) {
    int tid_ = threadIdx.x; asm volatile("" : "+v"(tid_));
    const int tid = tid_, lane = tid & 63, w = __builtin_amdgcn_readfirstlane(tid >> 6);
    const float* S = (const float*)(a.ws + WS_S); const float* AP = (const float*)(a.ws + WS_APOW); bf16_t* USX = (bf16_t*)(a.ws + WS_USX);
    LAS float* seg = (LAS float*)lds;
    for (int it = blockIdx.x; it < 128; it += gridDim.x) {
        const int g = it >> 2, b = it & 3, p = lane;
        const float alr = AP[(g * 64 + p) * 2], ali = AP[(g * 64 + p) * 2 + 1];
        const size_t row0 = (size_t)g * 1024 + b * 256 + 32 * w;
        float sr[32], si[32];
#pragma unroll
        for (int i = 0; i < 32; ++i) { sr[i] = S[(row0 + i) * 128 + p]; si[i] = S[(row0 + i) * 128 + 64 + p]; }
        float xr = 0.f, xi = 0.f;
#pragma unroll
        for (int i = 0; i < 32; ++i) { const float tr = xr, ti = xi; const float nr = alr * xr - ali * xi + sr[i], ni = alr * xi + ali * xr + si[i]; xr = nr; xi = ni; sr[i] = tr; si[i] = ti; }
        seg[(w * 64 + p) * 2] = xr; seg[(w * 64 + p) * 2 + 1] = xi;
        float a32r = alr, a32i = ali;
#pragma unroll
        for (int k = 0; k < 5; ++k) { const float tr = a32r * a32r - a32i * a32i, ti = 2.f * a32r * a32i; a32r = tr; a32i = ti; }
        __syncthreads();
        float x0r = 0.f, x0i = 0.f;
        for (int ww = 0; ww < w; ++ww) { const float er = seg[(ww * 64 + p) * 2], ei = seg[(ww * 64 + p) * 2 + 1]; const float nr = a32r * x0r - a32i * x0i + er, ni = a32r * x0i + a32i * x0r + ei; x0r = nr; x0i = ni; }
        float pr = 1.f, pi = 0.f;
#pragma unroll
        for (int i = 0; i < 32; ++i) {
            const float vr = sr[i] + pr * x0r - pi * x0i, vi = si[i] + pr * x0i + pi * x0r;
            bf16_t* d = USX + (row0 + i) * KX + 512 + p; d[0] = (bf16_t)f2bf(vr); d[64] = (bf16_t)f2bf(vi);
            const float tr = pr * alr - pi * ali, ti = pr * ali + pi * alr; pr = tr; pi = ti;
        }
        __syncthreads();
    }
}

__device__ __forceinline__ void attn_phase(LAS unsigned char* lds, const Args& a) {
    int tid_ = threadIdx.x; asm volatile("" : "+v"(tid_));
    const int tid = tid_, lane = tid & 63, w = __builtin_amdgcn_readfirstlane(tid >> 6), l31 = lane & 31, hi = lane >> 5;
    const bf16_t* __restrict__ QKV = (const bf16_t*)(a.ws + WS_QKV); bf16_t* __restrict__ YATT = (bf16_t*)(a.ws + WS_YATT);
    constexpr float LOG2E = 1.4426950408889634f, LN2 = 0.6931471805599453f, NEG_INF = -__builtin_inff();
    const int skey = tid >> 3, sch = tid & 7;
    const unsigned kst = skey * 128 + ((sch ^ ((skey >> 1) & 7)) << 4), vst = 8192 + skey * 128 + ((sch ^ (((skey >> 1) & 1) << 2)) << 4);
    unsigned koff[4];
#pragma unroll
    for (int s = 0; s < 4; ++s) koff[s] = l31 * 128 + (((2 * s + hi) ^ ((l31 >> 1) & 7)) << 4);
    const int tq = (lane & 15) >> 2, tc2 = 2 * ((lane >> 4) & 1) + ((lane & 3) >> 1), tb = (tq >> 1) & 1;
    const unsigned vbase = 8192 + (4 * hi + tq) * 128 + tc2 * 16 + (lane & 1) * 8;
    for (int L = blockIdx.x; L < 1024; L += gridDim.x) {
        const int bh = L & 31, qb = 31 - (L >> 5), b = bh >> 3, h = bh & 7, q0 = qb * 256;
        const size_t rowbase = (size_t)b * SEQ;
        const int qmin = q0 + 32 * w, qpos = qmin + l31;
        bf16x8 qf[4];
        { const bf16_t* qp = QKV + (rowbase + qpos) * 1536 + h * 64 + 8 * hi;
#pragma unroll
          for (int s = 0; s < 4; ++s) qf[s] = *(const bf16x8*)(qp + 16 * s); }
        f32x16 o0, o1;
#pragma unroll
        for (int r = 0; r < 16; ++r) { o0[r] = 0.f; o1[r] = 0.f; }
        float R = 0.f; bool wdone = false;
        const int jmax = qb * 4 + 3;
        const bf16_t* kvp = QKV + (rowbase + skey) * 1536 + 512 + h * 64 + sch * 8;
        u32x4 kreg = *(const u32x4*)(kvp + (size_t)jmax * 64 * 1536), vreg = *(const u32x4*)(kvp + (size_t)jmax * 64 * 1536 + 512);
        *(LAS u32x4*)(lds + kst) = kreg; *(LAS u32x4*)(lds + vst) = vreg;
        __syncthreads();
        int buf = 0;
        for (int j = jmax; j >= 0; --j) {
            if (j > 0) { kreg = *(const u32x4*)(kvp + (size_t)(j - 1) * 64 * 1536); vreg = *(const u32x4*)(kvp + (size_t)(j - 1) * 64 * 1536 + 512); }
            const int kbase = 64 * j;
            if (kbase < qmin + 31 && !wdone) {
                const LAS unsigned char* kb = lds + buf * 16384;
                f32x16 p0, p1;
#pragma unroll
                for (int r = 0; r < 16; ++r) { p0[r] = 0.f; p1[r] = 0.f; }
#pragma unroll
                for (int s = 0; s < 4; ++s) {
                    const bf16x8 k0 = *(const LAS bf16x8*)(kb + koff[s]), k1 = *(const LAS bf16x8*)(kb + koff[s] + 4096);
                    p0 = __builtin_amdgcn_mfma_f32_32x32x16_bf16(k0, qf[s], p0, 0, 0, 0);
                    p1 = __builtin_amdgcn_mfma_f32_32x32x16_bf16(k1, qf[s], p1, 0, 0, 0);
                }
                const bool need_mask = (kbase + 63 >= qmin);
                float lf0[16], lf1[16];
#pragma unroll
                for (int r = 0; r < 16; ++r) {
                    const int key0 = kbase + (r & 3) + 8 * (r >> 2) + 4 * hi;
                    { const float z = p0[r] * 0.125f; const float e = __builtin_amdgcn_exp2f(-fabsf(z) * LOG2E); const float sp = fmaxf(z, 0.f) + __builtin_amdgcn_logf(1.0f + e) * LN2;
                      float lfv = -sp, lsg = z - sp; if (need_mask && key0 >= qpos) { lfv = 0.f; lsg = NEG_INF; } lf0[r] = lfv; p0[r] = lsg; }
                    { const float z = p1[r] * 0.125f; const float e = __builtin_amdgcn_exp2f(-fabsf(z) * LOG2E); const float sp = fmaxf(z, 0.f) + __builtin_amdgcn_logf(1.0f + e) * LN2;
                      float lfv = -sp, lsg = z - sp; if (need_mask && key0 + 32 >= qpos) { lfv = 0.f; lsg = NEG_INF; } lf1[r] = lfv; p1[r] = lsg; }
                }
                float qs[8], ps[8];
#pragma unroll
                for (int g4 = 0; g4 < 4; ++g4) { qs[g4] = (lf0[4 * g4] + lf0[4 * g4 + 1]) + (lf0[4 * g4 + 2] + lf0[4 * g4 + 3]); qs[4 + g4] = (lf1[4 * g4] + lf1[4 * g4 + 1]) + (lf1[4 * g4 + 2] + lf1[4 * g4 + 3]); }
#pragma unroll
                for (int k = 0; k < 8; ++k) ps[k] = __shfl_xor(qs[k], 32);
                float run = 0.f;
#pragma unroll
                for (int k = 7; k >= 0; --k) {
                    const float base = R + run + (hi == 0 ? ps[k] : 0.f);
                    run += qs[k] + ps[k];
                    const int g4 = k & 3;
                    if (k < 4) {
                        const float a3 = base, a2 = a3 + lf0[4 * g4 + 3], a1 = a2 + lf0[4 * g4 + 2], a0 = a1 + lf0[4 * g4 + 1];
                        p0[4 * g4 + 3] = __builtin_amdgcn_exp2f((p0[4 * g4 + 3] + a3) * LOG2E); p0[4 * g4 + 2] = __builtin_amdgcn_exp2f((p0[4 * g4 + 2] + a2) * LOG2E);
                        p0[4 * g4 + 1] = __builtin_amdgcn_exp2f((p0[4 * g4 + 1] + a1) * LOG2E); p0[4 * g4 + 0] = __builtin_amdgcn_exp2f((p0[4 * g4 + 0] + a0) * LOG2E);
                    } else {
                        const float a3 = base, a2 = a3 + lf1[4 * g4 + 3], a1 = a2 + lf1[4 * g4 + 2], a0 = a1 + lf1[4 * g4 + 1];
                        p1[4 * g4 + 3] = __builtin_amdgcn_exp2f((p1[4 * g4 + 3] + a3) * LOG2E); p1[4 * g4 + 2] = __builtin_amdgcn_exp2f((p1[4 * g4 + 2] + a2) * LOG2E);
                        p1[4 * g4 + 1] = __builtin_amdgcn_exp2f((p1[4 * g4 + 1] + a1) * LOG2E); p1[4 * g4 + 0] = __builtin_amdgcn_exp2f((p1[4 * g4 + 0] + a0) * LOG2E);
                    }
                }
                R += run;
                bf16x8 pb[4];
#pragma unroll
                for (int s = 0; s < 2; ++s) {
                    u32x4 w0, w1;
                    w0.x = pg8::cvt_pk_bf16(p0[8 * s + 0], p0[8 * s + 1]); w0.y = pg8::cvt_pk_bf16(p0[8 * s + 2], p0[8 * s + 3]); w0.z = pg8::cvt_pk_bf16(p0[8 * s + 4], p0[8 * s + 5]); w0.w = pg8::cvt_pk_bf16(p0[8 * s + 6], p0[8 * s + 7]);
                    w1.x = pg8::cvt_pk_bf16(p1[8 * s + 0], p1[8 * s + 1]); w1.y = pg8::cvt_pk_bf16(p1[8 * s + 2], p1[8 * s + 3]); w1.z = pg8::cvt_pk_bf16(p1[8 * s + 4], p1[8 * s + 5]); w1.w = pg8::cvt_pk_bf16(p1[8 * s + 6], p1[8 * s + 7]);
                    pb[s] = __builtin_bit_cast(bf16x8, w0); pb[2 + s] = __builtin_bit_cast(bf16x8, w1);
                }
#pragma unroll
                for (int dblk = 0; dblk < 2; ++dblk)
#pragma unroll
                    for (int ss = 0; ss < 4; ++ss) {
                        const unsigned ad = vbase + ss * 2048 + ((dblk ^ tb) << 6);
                        const v4i16_t lo = __builtin_amdgcn_ds_read_tr16_b64_v4i16((LAS v4i16_t*)(kb + ad));
                        const v4i16_t hi4 = __builtin_amdgcn_ds_read_tr16_b64_v4i16((LAS v4i16_t*)(kb + ad + 1024));
                        bf16x8 vf; vf[0] = lo[0]; vf[1] = lo[1]; vf[2] = lo[2]; vf[3] = lo[3]; vf[4] = hi4[0]; vf[5] = hi4[1]; vf[6] = hi4[2]; vf[7] = hi4[3];
                        if (dblk == 0) o0 = __builtin_amdgcn_mfma_f32_32x32x16_bf16(vf, pb[ss], o0, 0, 0, 0);
                        else o1 = __builtin_amdgcn_mfma_f32_32x32x16_bf16(vf, pb[ss], o1, 0, 0, 0);
                    }
                wdone = __all(R < -100.0f);
            }
            if (j > 0) { *(LAS u32x4*)(lds + (buf ^ 1) * 16384 + kst) = kreg; *(LAS u32x4*)(lds + (buf ^ 1) * 16384 + vst) = vreg; }
            const int alld = __syncthreads_and(wdone ? 1 : 0);
            buf ^= 1;
            if (alld) break;
        }
        bf16_t* op = YATT + (rowbase + qpos) * 512 + h * 64 + 4 * hi;
#pragma unroll
        for (int g4 = 0; g4 < 4; ++g4) {
            u32x2 w0, w1;
            w0.x = pg8::cvt_pk_bf16(o0[4 * g4], o0[4 * g4 + 1]); w0.y = pg8::cvt_pk_bf16(o0[4 * g4 + 2], o0[4 * g4 + 3]);
            w1.x = pg8::cvt_pk_bf16(o1[4 * g4], o1[4 * g4 + 1]); w1.y = pg8::cvt_pk_bf16(o1[4 * g4 + 2], o1[4 * g4 + 3]);
            *(u32x2*)(op + 8 * g4) = w0; *(u32x2*)(op + 32 + 8 * g4) = w1;
        }
    }
}

__device__ __forceinline__ void final_phase(const Args& a) {
    const int tid = threadIdx.x, lane = tid & 63, wave = tid >> 6;
    const int gw = blockIdx.x * 8 + wave, NGW = gridDim.x * 8;
    const float* rs2 = (const float*)(a.ws + WS_CTL) + M; const float* gf = a.in[I_NFIN];
    f32x4 gv[4];
#pragma unroll
    for (int j = 0; j < 4; ++j) gv[j] = *((const f32x4*)gf + 64 * j + lane);
    for (int m = gw; m < M; m += NGW) {
        f32x4* xr = (f32x4*)(a.out + (size_t)m * DM) + lane;
        const float rstd = 1.0f / sqrtf(rs2[m] * (1.0f / DM) + EPSN);
#pragma unroll
        for (int j = 0; j < 4; ++j) { f32x4 v = xr[64 * j]; v = v * rstd * gv[j]; xr[64 * j] = v; }
    }
}

#define XB_TMO      128
#define XB_XCNT(j)  (256  + 64 * (j))
#define XB_XSUB(j)  (1280 + 64 * (j))
#define XB_XGEN(j)  (2304 + 64 * (j))
#define XB_TOP      3328
#define XB_TOPGEN   3392
#define XCD_BAR_WORDS 3456
#define XB_SPIN_CAP (1u << 18)

__device__ __forceinline__ unsigned xb_ld(unsigned* p)              { return __hip_atomic_load(p, __ATOMIC_RELAXED, __HIP_MEMORY_SCOPE_AGENT); }
__device__ __forceinline__ unsigned xb_add(unsigned* p, unsigned v) { return __hip_atomic_fetch_add(p, v, __ATOMIC_RELAXED, __HIP_MEMORY_SCOPE_AGENT); }
__device__ __forceinline__ unsigned xb_xcc_id() { return (unsigned)__builtin_amdgcn_s_getreg((3 << 11) | 20) & 0xFu; }
#define XB_SPIN(cond, bar) do { unsigned _sp = 0; while (cond) { __builtin_amdgcn_s_sleep(1); \
    if ((++_sp & 255u) == 0u) { if (xb_ld(&(bar)[XB_TMO])) break; if (_sp > XB_SPIN_CAP) { atomicAdd(&(bar)[XB_TMO], 1u); break; } } } } while (0)

struct XcdBarrier {
    unsigned* bar; unsigned x;
    volatile LAS unsigned* st;
};

__device__ __forceinline__ XcdBarrier xcd_barrier_post(unsigned* bar, volatile LAS unsigned* st) {
    XcdBarrier b; b.bar = bar; b.x = xb_xcc_id(); b.st = st;
    if (threadIdx.x == 0) (void)xb_add(&bar[XB_XCNT(b.x)], 1u);
    return b;
}
__device__ __forceinline__ void xcd_barrier_complete(unsigned* bar, unsigned x, unsigned& nloc, unsigned& nx) {
    const unsigned G = gridDim.x * gridDim.y * gridDim.z;
    unsigned sum, cnt, mine, sp = 0u;
    for (;;) {
        sum = 0u; cnt = 0u; mine = 0u;
#pragma unroll
        for (unsigned j = 0; j < 16; ++j) { const unsigned c = xb_ld(&bar[XB_XCNT(j)]); sum += c; cnt += (c > 0u) ? 1u : 0u; mine = (j == x) ? c : mine; }
        if (sum == G) break;
        __builtin_amdgcn_s_sleep(1);
        if ((++sp & 255u) == 0u) { if (xb_ld(&bar[XB_TMO])) break; if (sp > XB_SPIN_CAP) { atomicAdd(&bar[XB_TMO], 1u); break; } }
    }
    nloc = mine > 0u ? mine : 1u; nx = cnt > 0u ? cnt : 1u;
}

__device__ __forceinline__ void xcd_barrier(const XcdBarrier& b) {
    asm volatile("s_waitcnt vmcnt(0)" ::: "memory");
    __syncthreads();
    if (threadIdx.x == 0) {
        unsigned* bar = b.bar;
        __builtin_amdgcn_s_waitcnt(0);
        unsigned nloc = b.st[0], nx = b.st[1];
        if (nloc == 0u) { xcd_barrier_complete(bar, b.x, nloc, nx); b.st[0] = nloc; b.st[1] = nx; }
        const unsigned old = xb_add(&bar[XB_XSUB(b.x)], 1u);
        const unsigned gen = old / nloc;
        if (old + 1u == (gen + 1u) * nloc) {
            __builtin_amdgcn_fence(__ATOMIC_RELEASE, "agent");
            asm volatile("s_waitcnt vmcnt(0)" ::: "memory");
            const unsigned og = xb_add(&bar[XB_TOP], 1u);
            const unsigned tg = og / nx;
            if (og + 1u == (tg + 1u) * nx) xb_add(&bar[XB_TOPGEN], 1u);
            else XB_SPIN(xb_ld(&bar[XB_TOPGEN]) == tg, bar);
            __builtin_amdgcn_fence(__ATOMIC_ACQUIRE, "agent");
            xb_add(&bar[XB_XGEN(b.x)], 1u);
            asm volatile("s_waitcnt vmcnt(0)" ::: "memory");
        } else {
            XB_SPIN(xb_ld(&bar[XB_XGEN(b.x)]) == gen, bar);
            __builtin_amdgcn_fence(__ATOMIC_ACQUIRE, "agent");
            asm volatile("s_waitcnt vmcnt(0)" ::: "memory");
        }
    }
    __syncthreads();
}

constexpr size_t WS_BAR = 512 * 1024;
constexpr int LDS_MISC = 131072 + 256;
__global__ void __launch_bounds__(512, 2) fwd_megakernel(Args a) {
    extern __shared__ __attribute__((aligned(16))) unsigned char lds_raw[];
    LAS unsigned char* lds = (LAS unsigned char*)lds_raw;
    cg::grid_group grid = cg::this_grid();
    const int G = gridDim.x, c = blockIdx.x;
    unsigned char* ws = a.ws;
    if (ws == nullptr) grid.sync();
    volatile LAS unsigned* bst = (volatile LAS unsigned*)(lds + LDS_MISC);
    if (threadIdx.x < 2) bst[threadIdx.x] = 0u;
    __syncthreads();
    const XcdBarrier xbar = xcd_barrier_post((unsigned*)(ws + WS_BAR), bst);
#define GRID_SYNC() xcd_barrier(xbar)
    bf16_t* USX = (bf16_t*)(ws + WS_USX); bf16_t* QKV = (bf16_t*)(ws + WS_QKV); bf16_t* GATES = (bf16_t*)(ws + WS_GATES);
    bf16_t* Y1 = (bf16_t*)(ws + WS_Y1); bf16_t* Y2 = (bf16_t*)(ws + WS_Y2); bf16_t* YATT = (bf16_t*)(ws + WS_YATT);
    bf16_t* T1 = (bf16_t*)(ws + WS_XN); bf16_t* HN = (bf16_t*)(ws + WS_QKV); bf16_t* HID = (bf16_t*)(ws + WS_HID);
    float* rs1 = (float*)(ws + WS_CTL); float* rs2 = rs1 + M;
    prologue(lds, a);
    GRID_SYNC();
    { pg8::Gemm g{(const bf16_t*)(ws + WS_XN), (const bf16_t*)(ws + WS_WCAT), 1024, 1024}; pg8::StaticOrder S; S.init(M, 4096, G, c);
      pg8::EpiProj E{USX, QKV, GATES, a.in[I_BGATE]};
      pg8::gemm_phase<pg8::EpiProj, pg8::StaticOrder, true, true>(lds, g, S, E); }
    GRID_SYNC();
    { pg8::Gemm g{USX, (const bf16_t*)(ws + WS_HH), KX, 512}; pg8::GroupOrder S{128, G, c, 0};
      pg8::EpiState E{(float*)(ws + WS_S)};
      pg8::gemm_phase<pg8::EpiState, pg8::GroupOrder, true, true>(lds, g, S, E); }
    GRID_SYNC();
    scan_phase(lds, a);
    attn_phase(lds, a);
    GRID_SYNC();
    { pg8::Gemm g{USX, (const bf16_t*)(ws + WS_TG), KX, KX}; pg8::GroupOrder S{256, G, c, 1};
      pg8::EpiSsmY E{Y1};
      pg8::gemm_phase<pg8::EpiSsmY, pg8::GroupOrder, true, true>(lds, g, S, E); }
    GRID_SYNC();
    { pg8::Gemm g{Y1, (const bf16_t*)(ws + WS_WGLU), 512, 512}; pg8::StaticOrder S; S.init(M, 512, G, c);
      pg8::EpiGlu E{Y1, Y2, a.in[I_BGLU]};
      pg8::gemm_phase<pg8::EpiGlu, pg8::StaticOrder, true, true>(lds, g, S, E); }
    GRID_SYNC();
    { pg8::Gemm g{Y2, (const bf16_t*)(ws + WS_WUPS), 512, 512}; pg8::StaticOrder S; S.init(M, 1024, G, c);
      pg8::EpiUp<false> E{GATES, T1, 0};
      pg8::gemm_phase<pg8::EpiUp<false>, pg8::StaticOrder, true, true>(lds, g, S, E); }
    { pg8::Gemm g{YATT, (const bf16_t*)(ws + WS_WUPA), 512, 512}; pg8::StaticOrder S; S.init(M, 1024, G, c);
      pg8::EpiUp<true> E{GATES, T1, 1024};
      pg8::gemm_phase<pg8::EpiUp<true>, pg8::StaticOrder, true, true>(lds, g, S, E); }
    GRID_SYNC();
    { pg8::Gemm g{T1, (const bf16_t*)(ws + WS_WOUT), 1024, 1024}; pg8::StaticOrder S; S.init(M, 1024, G, c);
      pg8::EpiOut E{a.in[I_X], a.out, HN, a.in[I_NMLP], rs1};
      pg8::gemm_phase<pg8::EpiOut, pg8::StaticOrder, true, true>(lds, g, S, E); }
    GRID_SYNC();
    { pg8::Gemm g{HN, (const bf16_t*)(ws + WS_W1), 1024, 1024}; pg8::StaticOrder S; S.init(M, 4096, G, c);
      pg8::EpiFf1 E{rs1, HID};
      pg8::gemm_phase<pg8::EpiFf1, pg8::StaticOrder, true, true>(lds, g, S, E); }
    GRID_SYNC();
    { pg8::Gemm g{HID, (const bf16_t*)(ws + WS_W2), 4096, 4096}; pg8::StaticOrder S; S.init(M, 1024, G, c);
      pg8::EpiFf2 E{a.out, rs2};
      pg8::gemm_phase<pg8::EpiFf2, pg8::StaticOrder, true, true>(lds, g, S, E); }
    GRID_SYNC();
    final_phase(a);
}

extern "C" void kernel_launch(void* const* d_in, const int* in_sizes, int n_in, void* d_out, int out_size, void* d_ws, size_t ws_size, hipStream_t stream) {
    static int grid = 0;
    if (grid == 0) {
        if (n_in != 22 || in_sizes[0] != M * DM || out_size != M * DM || ws_size < WS_END) { fprintf(stderr, "kernel_launch: unexpected shapes (n_in %d, in0 %d, out %d, ws %zu); nothing launched\n", n_in, n_in > 0 ? in_sizes[0] : -1, out_size, ws_size); grid = -1; return; }
        int dev = 0, cus = 0, per_cu = 0;
        (void)hipGetDevice(&dev);
        (void)hipDeviceGetAttribute(&cus, hipDeviceAttributeMultiprocessorCount, dev);
        (void)hipFuncSetAttribute((const void*)fwd_megakernel, hipFuncAttributeMaxDynamicSharedMemorySize, LDS_BYTES);
        (void)hipOccupancyMaxActiveBlocksPerMultiprocessor(&per_cu, (const void*)fwd_megakernel, 512, LDS_BYTES);
        if (per_cu < 1) per_cu = 1;
        grid = cus * per_cu;
        fprintf(stderr, "kernel_launch: grid %d (cus %d x %d)\n", grid, cus, per_cu);
    }
    if (grid < 0) return;
    Args a{};
    for (int i = 0; i < 22; ++i) a.in[i] = (const float*)d_in[i];
    a.out = (float*)d_out; a.ws = (unsigned char*)d_ws;
    void* args[] = {&a};
    (void)hipMemsetAsync((unsigned char*)d_ws + WS_BAR, 0, XCD_BAR_WORDS * 4, stream);
    hipError_t e = hipLaunchCooperativeKernel((const void*)fwd_megakernel, dim3(grid), dim3(512), args, LDS_BYTES, stream);
    if (e != hipSuccess) fprintf(stderr, "cooperative launch failed: %s (grid %d)\n", hipGetErrorString(e), grid);
}
```

```cpp
#include <hip/hip_runtime.h>
#include <hip/hip_cooperative_groups.h>
#include <cstdio>
#include <cstdint>
namespace cg = cooperative_groups;

namespace pg8 {
#define PG8_LAS __attribute__((address_space(3)))
typedef unsigned short bf16_t;
typedef short bf16x8 __attribute__((ext_vector_type(8)));
typedef float f32x4 __attribute__((ext_vector_type(4)));
typedef float f32x16 __attribute__((ext_vector_type(16)));
typedef unsigned u32x4 __attribute__((ext_vector_type(4)));
typedef unsigned u32x2 __attribute__((ext_vector_type(2)));
constexpr int BM = 256, BK = 64, HALF = 128, HTB = HALF * BK * 2, STAGE_BYTES = 8 * HTB, NXCD = 8, WGM = 8;
__host__ __device__ __forceinline__ int lds_byte(int r, int c) { const int st = (r >> 4) * 2 + (c >> 5), rr = r & 15, cc = c & 31, ob = rr * 64 + cc * 2; return st * 1024 + (ob ^ (((ob >> 9) & 1) << 5)); }
__host__ __device__ __forceinline__ void stage_rc(int b, int& R, int& C) { const int st = b / 1024, sb = b % 1024, swz = sb ^ (((sb >> 9) & 1) << 5); R = (st >> 1) * 16 + swz / 64; C = (st & 1) * 32 + (swz % 64) / 2; }
__host__ __device__ __forceinline__ int perm32(int rho) { const int n = rho >> 4, i = rho & 15; return 8 * (i >> 2) + 4 * n + (i & 3); }
struct Unit { int pm, pn; };
struct Gemm { const bf16_t* A; const bf16_t* Bt; int lda, K; };
struct StaticOrder {
    int nM, nN, nwg, G, c;
    __host__ __device__ void init(int M, int N, int G_, int c_) { nM = M / BM; nN = N / BM; nwg = nM * nN; G = G_; c = c_; }
    __host__ __device__ bool next(int i, Unit& u) const {
        const long L = (long)i * G + c; if (L >= nwg) return false;
        int wgid = (int)L; { const int q = nwg / NXCD, r = nwg % NXCD, xcd = wgid % NXCD, off = wgid / NXCD; wgid = (xcd < r ? xcd * (q + 1) : r * (q + 1) + (xcd - r) * q) + off; }
        const int nig = WGM * nN, gid = wgid / nig, fm = gid * WGM, gsz = (nM - fm) < WGM ? (nM - fm) : WGM;
        u.pm = fm + ((wgid % nig) % gsz); u.pn = (wgid % nig) / gsz; return true;
    }
    __device__ __forceinline__ void a_ready(const Unit&) const {}
    __device__ __forceinline__ void done(const Unit&) const {}
};
struct GroupOrder {
    int nunits, G, c, mode;
    __host__ __device__ bool next(int i, Unit& u) const {
        const int L = i * G + c; if (L >= nunits) return false;
        if (mode == 0) { u.pm = L; u.pn = L >> 2; } else { const int g = L >> 3; u.pm = 4 * g + (L & 3); u.pn = 2 * g + ((L >> 2) & 1); }
        return true;
    }
    __device__ __forceinline__ void a_ready(const Unit&) const {}
    __device__ __forceinline__ void done(const Unit&) const {}
};
__device__ __forceinline__ unsigned cvt_pk_bf16(float lo, float hi) { unsigned r; asm volatile("v_cvt_pk_bf16_f32 %0, %1, %2" : "=v"(r) : "v"(lo), "v"(hi)); return r; }
__device__ __forceinline__ u32x4 pack8(f32x4 a, f32x4 b) { u32x4 w; w.x = cvt_pk_bf16(a[0], a[1]); w.y = cvt_pk_bf16(a[2], a[3]); w.z = cvt_pk_bf16(b[0], b[1]); w.w = cvt_pk_bf16(b[2], b[3]); return w; }
__device__ __forceinline__ void unpack8(u32x4 w, f32x4& a, f32x4& b) {
    a[0] = __uint_as_float(w.x << 16); a[1] = __uint_as_float(w.x & 0xffff0000u); a[2] = __uint_as_float(w.y << 16); a[3] = __uint_as_float(w.y & 0xffff0000u);
    b[0] = __uint_as_float(w.z << 16); b[1] = __uint_as_float(w.z & 0xffff0000u); b[2] = __uint_as_float(w.w << 16); b[3] = __uint_as_float(w.w & 0xffff0000u);
}
__device__ __forceinline__ float sigmoidf_(float x) { return __builtin_amdgcn_rcpf(1.0f + __builtin_amdgcn_exp2f(-1.4426950408889634f * x)); }
__device__ __forceinline__ f32x4 sigmoid4(f32x4 v) { f32x4 o; o[0] = sigmoidf_(v[0]); o[1] = sigmoidf_(v[1]); o[2] = sigmoidf_(v[2]); o[3] = sigmoidf_(v[3]); return o; }

#define EPI_ARGS const f32x4 (&acc)[2][2][4][2], const Unit& u, int wr, int wc, int fr, int fq
#define EPI_LOOP_BEGIN \
    _Pragma("unroll") for (int ai = 0; ai < 2; ++ai) _Pragma("unroll") for (int m = 0; m < 4; ++m) { const int row = u.pm * 256 + ai * 128 + wr * 64 + m * 16 + fr; \
    _Pragma("unroll") for (int bj = 0; bj < 2; ++bj) { const int col = u.pn * 256 + bj * 128 + wc * 32 + 8 * fq; f32x4 v0 = acc[ai][bj][m][0], v1 = acc[ai][bj][m][1];
#define EPI_LOOP_END } }

struct EpiProj {
    static constexpr bool PERM = true, AFTER_DRAIN = false;
    bf16_t* usx; bf16_t* qkv; bf16_t* gates; const float* bgate;
    __device__ __forceinline__ void operator()(EPI_ARGS) const {
        const int colt = u.pn * 256;
        if (colt < 512) {
            EPI_LOOP_BEGIN
                const int g = col >> 4, ci0 = col & 15, chunk = row >> 5, t = row & 31;
                *(u32x4*)(usx + ((size_t)(g * 1024 + chunk)) * 640 + t * 16 + ci0) = pack8(v0, v1);
            EPI_LOOP_END
        } else if (colt < 2048) {
            EPI_LOOP_BEGIN
                *(u32x4*)(qkv + (size_t)row * 1536 + (col - 512)) = pack8(v0, v1);
            EPI_LOOP_END
        } else {
            EPI_LOOP_BEGIN
                const int c2 = col - 2048;
                const f32x4 b0 = *(const f32x4*)(bgate + c2), b1 = *(const f32x4*)(bgate + c2 + 4);
                *(u32x4*)(gates + (size_t)row * 2048 + c2) = pack8(sigmoid4(v0 + b0), sigmoid4(v1 + b1));
            EPI_LOOP_END
        }
    }
};
struct EpiState {
    static constexpr bool PERM = true, AFTER_DRAIN = false;
    float* S;
    __device__ __forceinline__ void operator()(EPI_ARGS) const {
        EPI_LOOP_BEGIN
            if (bj == 0) { const int cl = wc * 32 + 8 * fq; float* d = S + (size_t)row * 128 + cl; *(f32x4*)d = v0; *(f32x4*)(d + 4) = v1; }
            (void)col;
        EPI_LOOP_END
    }
};
__device__ __forceinline__ float gelu_tanh_(float x) { const float u = 0.7978845608028654f * (x + 0.044715f * x * x * x); return x * sigmoidf_(2.0f * u); }
struct EpiSsmY {
    static constexpr bool PERM = true, AFTER_DRAIN = false;
    bf16_t* Y1;
    __device__ __forceinline__ void operator()(EPI_ARGS) const {
        EPI_LOOP_BEGIN
            const int g = row >> 10, chunkg = row & 1023, cl = (col & 511), t = cl >> 4, co0 = cl & 15;
            f32x4 a, b;
#pragma unroll
            for (int e = 0; e < 4; ++e) { a[e] = gelu_tanh_(v0[e]); b[e] = gelu_tanh_(v1[e]); }
            *(u32x4*)(Y1 + (size_t)(chunkg * 32 + t) * 512 + g * 16 + co0) = pack8(a, b);
        EPI_LOOP_END
    }
};
struct EpiGlu {
    static constexpr bool PERM = true, AFTER_DRAIN = false;
    const bf16_t* Y1; bf16_t* Y2; const float* bglu;
    __device__ __forceinline__ void operator()(EPI_ARGS) const {
        EPI_LOOP_BEGIN
            const f32x4 b0 = *(const f32x4*)(bglu + col), b1 = *(const f32x4*)(bglu + col + 4);
            f32x4 y0, y1; unpack8(*(const u32x4*)(Y1 + (size_t)row * 512 + col), y0, y1);
            *(u32x4*)(Y2 + (size_t)row * 512 + col) = pack8(y0 * sigmoid4(v0 + b0), y1 * sigmoid4(v1 + b1));
        EPI_LOOP_END
    }
};
template <bool ADD> struct EpiUp {
    static constexpr bool PERM = true, AFTER_DRAIN = false;
    const bf16_t* gates; bf16_t* T1; int goff;
    __device__ __forceinline__ void operator()(EPI_ARGS) const {
        EPI_LOOP_BEGIN
            f32x4 g0, g1; unpack8(*(const u32x4*)(gates + (size_t)row * 2048 + goff + col), g0, g1);
            f32x4 r0 = g0 * v0, r1 = g1 * v1;
            bf16_t* d = T1 + (size_t)row * 1024 + col;
            if (ADD) { f32x4 t0, t1; unpack8(*(const u32x4*)d, t0, t1); r0 += t0; r1 += t1; }
            *(u32x4*)d = pack8(r0, r1);
        EPI_LOOP_END
    }
};
struct EpiOut {
    static constexpr bool PERM = true, AFTER_DRAIN = false;
    const float* x; float* hout; bf16_t* HN; const float* gn; float* rowss;
    __device__ __forceinline__ void operator()(EPI_ARGS) const {
#pragma unroll
        for (int ai = 0; ai < 2; ++ai)
#pragma unroll
            for (int m = 0; m < 4; ++m) {
                const int row = u.pm * 256 + ai * 128 + wr * 64 + m * 16 + fr; float ss = 0.f;
#pragma unroll
                for (int bj = 0; bj < 2; ++bj) {
                    const int col = u.pn * 256 + bj * 128 + wc * 32 + 8 * fq; const size_t o = (size_t)row * 1024 + col;
                    const f32x4 h0 = *(const f32x4*)(x + o) + acc[ai][bj][m][0], h1 = *(const f32x4*)(x + o + 4) + acc[ai][bj][m][1];
                    *(f32x4*)(hout + o) = h0; *(f32x4*)(hout + o + 4) = h1;
                    const f32x4 n0 = *(const f32x4*)(gn + col), n1 = *(const f32x4*)(gn + col + 4);
                    *(u32x4*)(HN + o) = pack8(h0 * n0, h1 * n1);
                    const f32x4 q0 = h0 * h0, q1 = h1 * h1; ss += (q0[0] + q0[1]) + (q0[2] + q0[3]) + (q1[0] + q1[1]) + (q1[2] + q1[3]);
                }
                ss += __shfl_xor(ss, 16); ss += __shfl_xor(ss, 32);
                if (fq == 0) atomicAdd(rowss + row, ss);
            }
    }
};
struct EpiFf1 {
    static constexpr bool PERM = true, AFTER_DRAIN = false;
    const float* rowss; bf16_t* HID;
    __device__ __forceinline__ void operator()(EPI_ARGS) const {
#pragma unroll
        for (int ai = 0; ai < 2; ++ai)
#pragma unroll
            for (int m = 0; m < 4; ++m) {
                const int row = u.pm * 256 + ai * 128 + wr * 64 + m * 16 + fr;
                const float r2 = 1.0f / (rowss[row] * (1.0f / 1024.0f) + 1e-6f);
#pragma unroll
                for (int bj = 0; bj < 2; ++bj) {
                    const int col = u.pn * 256 + bj * 128 + wc * 32 + 8 * fq;
                    f32x4 a = acc[ai][bj][m][0], b = acc[ai][bj][m][1];
#pragma unroll
                    for (int e = 0; e < 4; ++e) { const float p = fmaxf(a[e], 0.f), q = fmaxf(b[e], 0.f); a[e] = p * p * r2; b[e] = q * q * r2; }
                    *(u32x4*)(HID + (size_t)row * 4096 + col) = pack8(a, b);
                }
            }
    }
};
struct EpiFf2 {
    static constexpr bool PERM = true, AFTER_DRAIN = false;
    float* h; float* rowss;
    __device__ __forceinline__ void operator()(EPI_ARGS) const {
#pragma unroll
        for (int ai = 0; ai < 2; ++ai)
#pragma unroll
            for (int m = 0; m < 4; ++m) {
                const int row = u.pm * 256 + ai * 128 + wr * 64 + m * 16 + fr; float ss = 0.f;
#pragma unroll
                for (int bj = 0; bj < 2; ++bj) {
                    const int col = u.pn * 256 + bj * 128 + wc * 32 + 8 * fq; const size_t o = (size_t)row * 1024 + col;
                    const f32x4 h0 = *(const f32x4*)(h + o) + acc[ai][bj][m][0], h1 = *(const f32x4*)(h + o + 4) + acc[ai][bj][m][1];
                    *(f32x4*)(h + o) = h0; *(f32x4*)(h + o + 4) = h1;
                    const f32x4 q0 = h0 * h0, q1 = h1 * h1; ss += (q0[0] + q0[1]) + (q0[2] + q0[3]) + (q1[0] + q1[1]) + (q1[2] + q1[3]);
                }
                ss += __shfl_xor(ss, 16); ss += __shfl_xor(ss, 32);
                if (fq == 0) atomicAdd(rowss + row, ss);
            }
    }
};

template <class Epi, class Sched, bool ALIGN_EPI = false, bool SP2 = false>
__device__ __forceinline__ void gemm_phase(PG8_LAS unsigned char* lds, const Gemm g, const Sched& S, const Epi& E) {
    int tid_ = threadIdx.x; asm volatile("" : "+v"(tid_));
    const int tid = tid_, wid = __builtin_amdgcn_readfirstlane(tid >> 6), lane = tid & 63, wr = wid >> 2, wc = wid & 3, fr = lane & 15, fq = lane >> 4;
    const int K = g.K, nt = K / BK;
    unsigned voffA[2], voffB[2];
#pragma unroll
    for (int i = 0; i < 2; ++i) { int R, C; stage_rc(tid * 16 + i * 8192, R, C); const int Rb = Epi::PERM ? ((R & ~31) + perm32(R & 31)) : R;
        voffA[i] = (unsigned)(R * g.lda + C) * 2u; voffB[i] = (unsigned)(Rb * K + C) * 2u; }
    const size_t kstep = (size_t)(BK * 2);
    const size_t hstepA = (size_t)HALF * g.lda * 2, hstepB = (size_t)HALF * K * 2;
    const size_t tstepA = 2 * hstepA, tstepB = 2 * hstepB;
    const unsigned ldsw = (unsigned)wid * 1024u;
    const int aoff = lds_byte(wr * 64 + fr, fq * 8), boff = lds_byte(wc * 32 + fr, fq * 8);
#define PG8_SA(b, h) (((b) * 2 + (h)) * HTB)
#define PG8_SB(b, h) ((4 + (b) * 2 + (h)) * HTB)
#define PG8_STAGE(bufoff, gbase, voff) do { _Pragma("unroll") for (int _i = 0; _i < 2; ++_i) \
        __builtin_amdgcn_global_load_lds((const unsigned*)((const char*)(gbase) + (voff)[_i]), (PG8_LAS unsigned*)(lds + (bufoff) + ldsw + _i * 8192), 16, 0, 0); } while (0)
#define PG8_LDA(dst, b, h) do { _Pragma("unroll") for (int m = 0; m < 4; ++m) _Pragma("unroll") for (int k = 0; k < 2; ++k) dst[m][k] = *(const PG8_LAS bf16x8*)(lds + PG8_SA(b, h) + aoff + m * 2048 + k * 1024); } while (0)
#define PG8_LDB(dst, b, h) do { _Pragma("unroll") for (int n = 0; n < 2; ++n) _Pragma("unroll") for (int k = 0; k < 2; ++k) dst[n][k] = *(const PG8_LAS bf16x8*)(lds + PG8_SB(b, h) + boff + n * 2048 + k * 1024); } while (0)
#define PG8_MMA(ai, bj, At, Bt) do { __builtin_amdgcn_s_setprio(1); _Pragma("unroll") for (int m = 0; m < 4; ++m) _Pragma("unroll") for (int n = 0; n < 2; ++n) _Pragma("unroll") for (int k = 0; k < 2; ++k) \
        acc[ai][bj][m][n] = __builtin_amdgcn_mfma_f32_16x16x32_bf16(Bt[n][k], At[m][k], acc[ai][bj][m][n], 0, 0, 0); __builtin_amdgcn_s_setprio(0); } while (0)
#define PG8_WAIT_V(n) asm volatile("s_waitcnt vmcnt(" #n ")" ::: "memory")
#define PG8_WAIT_L(n) asm volatile("s_waitcnt lgkmcnt(" #n ")" ::: "memory")
#define PG8_BAR __builtin_amdgcn_s_barrier()
#define PG8_SCHED __builtin_amdgcn_sched_barrier(0)
    Unit cur, nxt; int ui = 0;
    if (!S.next(0, cur)) return;
    f32x4 acc[2][2][4][2];
#pragma unroll
    for (int a = 0; a < 2; ++a)
#pragma unroll
        for (int b = 0; b < 2; ++b)
#pragma unroll
            for (int m = 0; m < 4; ++m)
#pragma unroll
                for (int n = 0; n < 2; ++n) acc[a][b][m][n] = (f32x4){0.f, 0.f, 0.f, 0.f};
    bf16x8 At[4][2], B0[2][2], B1[2][2];
    const char* cA = (const char*)g.A + (size_t)cur.pm * tstepA; const char* cB = (const char*)g.Bt + (size_t)cur.pn * tstepB;
    S.a_ready(cur);
    if constexpr (SP2) {
        PG8_STAGE(PG8_SB(0, 0), cB, voffB); PG8_STAGE(PG8_SB(0, 1), cB + hstepB, voffB); PG8_STAGE(PG8_SA(0, 0), cA, voffA); PG8_STAGE(PG8_SA(0, 1), cA + hstepA, voffA);
        if (wr == 1) PG8_BAR;
        PG8_WAIT_V(2); PG8_BAR;
        PG8_STAGE(PG8_SB(1, 0), cB + kstep, voffB); PG8_STAGE(PG8_SA(1, 0), cA + kstep, voffA); PG8_STAGE(PG8_SB(1, 1), cB + hstepB + kstep, voffB);
        PG8_WAIT_V(6); PG8_BAR;
    } else {
        PG8_STAGE(PG8_SB(0, 0), cB, voffB); PG8_STAGE(PG8_SA(0, 0), cA, voffA); PG8_STAGE(PG8_SB(0, 1), cB + hstepB, voffB); PG8_STAGE(PG8_SA(0, 1), cA + hstepA, voffA);
        if (wr == 1) PG8_BAR;
        PG8_WAIT_V(4); PG8_BAR;
        PG8_STAGE(PG8_SB(1, 0), cB + kstep, voffB); PG8_STAGE(PG8_SA(1, 0), cA + kstep, voffA); PG8_STAGE(PG8_SB(1, 1), cB + hstepB + kstep, voffB);
        PG8_WAIT_V(6); PG8_BAR;
    }
    for (;;) {
        const bool has_next = S.next(ui + 1, nxt);
        const char* nA = has_next ? (const char*)g.A + (size_t)nxt.pm * tstepA : cA; const char* nB = has_next ? (const char*)g.Bt + (size_t)nxt.pn * tstepB : cB;
        for (int t = 0; t < nt; t += 2) {
            const bool last = (t == nt - 2);
            const char* a1 = cA + (size_t)(t + 1) * kstep;
            const char* a2 = last ? nA : cA + (size_t)(t + 2) * kstep; const char* b2 = last ? nB : cB + (size_t)(t + 2) * kstep;
            const char* a3 = a2 + kstep; const char* b3 = b2 + kstep;
            if (last && has_next) S.a_ready(nxt);
            if constexpr (SP2) {
            PG8_LDB(B0, 0, 0); PG8_LDB(B1, 0, 1); PG8_SCHED; PG8_LDA(At, 0, 0); PG8_STAGE(PG8_SA(1, 1), a1 + hstepA, voffA);
            PG8_WAIT_V(8); PG8_WAIT_L(0); PG8_BAR; PG8_MMA(0, 0, At, B0); PG8_MMA(0, 1, At, B1); PG8_BAR; PG8_SCHED;
            PG8_LDA(At, 0, 1); PG8_STAGE(PG8_SB(0, 0), b2, voffB); PG8_STAGE(PG8_SB(0, 1), b2 + hstepB, voffB); PG8_STAGE(PG8_SA(0, 0), a2, voffA);
            PG8_WAIT_V(8); PG8_WAIT_L(0); PG8_BAR; PG8_MMA(1, 0, At, B0); PG8_MMA(1, 1, At, B1); PG8_BAR; PG8_SCHED;
            PG8_LDB(B0, 1, 0); PG8_LDB(B1, 1, 1); PG8_SCHED; PG8_LDA(At, 1, 0); PG8_STAGE(PG8_SA(0, 1), a2 + hstepA, voffA);
            PG8_WAIT_V(8); PG8_WAIT_L(0); PG8_BAR; PG8_MMA(0, 0, At, B0); PG8_MMA(0, 1, At, B1); PG8_BAR; PG8_SCHED;
            PG8_LDA(At, 1, 1); PG8_STAGE(PG8_SB(1, 0), b3, voffB); PG8_STAGE(PG8_SB(1, 1), b3 + hstepB, voffB); PG8_STAGE(PG8_SA(1, 0), a3, voffA);
            PG8_WAIT_V(8); PG8_WAIT_L(0); PG8_BAR; PG8_MMA(1, 0, At, B0); PG8_MMA(1, 1, At, B1); PG8_BAR; PG8_SCHED;
            } else {
            PG8_LDB(B0, 0, 0); PG8_SCHED; PG8_LDA(At, 0, 0); PG8_STAGE(PG8_SA(1, 1), a1 + hstepA, voffA);
            PG8_WAIT_L(8); PG8_BAR; PG8_WAIT_L(0); PG8_MMA(0, 0, At, B0); PG8_BAR; PG8_SCHED;
            PG8_LDB(B1, 0, 1); PG8_STAGE(PG8_SB(0, 0), b2, voffB);
            PG8_BAR; PG8_WAIT_L(0); PG8_MMA(0, 1, At, B1); PG8_BAR;
            PG8_LDA(At, 0, 1); PG8_STAGE(PG8_SA(0, 0), a2, voffA);
            PG8_BAR; PG8_WAIT_L(0); PG8_MMA(1, 0, At, B0); PG8_BAR; PG8_SCHED;
            PG8_STAGE(PG8_SB(0, 1), b2 + hstepB, voffB);
            PG8_WAIT_V(6); PG8_BAR; PG8_MMA(1, 1, At, B1); PG8_BAR;
            PG8_LDB(B0, 1, 0); PG8_SCHED; PG8_LDA(At, 1, 0); PG8_STAGE(PG8_SA(0, 1), a2 + hstepA, voffA);
            PG8_WAIT_L(8); PG8_BAR; PG8_WAIT_L(0); PG8_MMA(0, 0, At, B0); PG8_BAR; PG8_SCHED;
            PG8_LDB(B1, 1, 1); PG8_STAGE(PG8_SB(1, 0), b3, voffB);
            PG8_BAR; PG8_WAIT_L(0); PG8_MMA(0, 1, At, B1); PG8_BAR;
            PG8_LDA(At, 1, 1); PG8_STAGE(PG8_SA(1, 0), a3, voffA);
            PG8_BAR; PG8_WAIT_L(0); PG8_MMA(1, 0, At, B0); PG8_BAR; PG8_SCHED;
            PG8_STAGE(PG8_SB(1, 1), b3 + hstepB, voffB);
            PG8_WAIT_V(6); PG8_BAR; PG8_MMA(1, 1, At, B1); PG8_BAR;
            }
        }
        if constexpr (ALIGN_EPI) { if (wr == 0) PG8_BAR; }
        if constexpr (!Epi::AFTER_DRAIN) { E(acc, cur, wr, wc, fr, fq); S.done(cur); }
        if (!has_next) break;
#pragma unroll
        for (int a = 0; a < 2; ++a)
#pragma unroll
            for (int b = 0; b < 2; ++b)
#pragma unroll
                for (int m = 0; m < 4; ++m)
#pragma unroll
                    for (int n = 0; n < 2; ++n) acc[a][b][m][n] = (f32x4){0.f, 0.f, 0.f, 0.f};
        cur = nxt; cA = nA; cB = nB; ++ui;
        if constexpr (ALIGN_EPI) { if (wr == 1) PG8_BAR; }
    }
    PG8_WAIT_V(0);
    if constexpr (!ALIGN_EPI) { if (wr == 0) PG8_BAR; }
    PG8_BAR;
    if constexpr (Epi::AFTER_DRAIN) { E.fused(acc, cur, wr, wc, fr, fq, lds, wid, lane); S.done(cur); }
#undef PG8_SA
#undef PG8_SB
#undef PG8_STAGE
#undef PG8_LDA
#undef PG8_LDB
#undef PG8_MMA
#undef PG8_WAIT_V
#undef PG8_WAIT_L
#undef PG8_BAR
#undef PG8_SCHED
}
}

using pg8::bf16_t; using pg8::bf16x8; using pg8::f32x4; using pg8::f32x16; using pg8::u32x4; using pg8::u32x2;
#define LAS __attribute__((address_space(3)))
typedef short v4i16_t __attribute__((ext_vector_type(4)));

constexpr int DM = 1024, NBATCH = 4, SEQ = 8192, M = NBATCH * SEQ, DSSM = 512, NG = 32, NST = 64, NHEAD = 8, DFF = 4096;
constexpr int LCH = 32, NCHG = M / LCH  , KX = 640;
constexpr float EPSN = 1e-6f;
constexpr size_t MiB = 1u << 20;
constexpr size_t WS_CTL = 0;
constexpr size_t WS_WCAT = 1 * MiB, WS_WGLU = 9 * MiB, WS_WUPS = 10 * MiB, WS_WUPA = 11 * MiB, WS_WOUT = 12 * MiB, WS_W1 = 14 * MiB, WS_W2 = 22 * MiB;
constexpr size_t WS_TG = 32 * MiB, WS_HH = 52 * MiB, WS_APOW = 60 * MiB, WS_S = 64 * MiB, WS_USX = 84 * MiB;
constexpr size_t WS_XN = 128 * MiB;
constexpr size_t WS_QKV = 192 * MiB;
constexpr size_t WS_GATES = 288 * MiB, WS_Y1 = 416 * MiB, WS_Y2 = 448 * MiB, WS_YATT = 480 * MiB;
constexpr size_t WS_HID = 256 * MiB, WS_END = 512 * MiB;
constexpr int LDS_BYTES = 147456;

__device__ __forceinline__ unsigned f2bf(float f) { unsigned u = __builtin_bit_cast(unsigned, f); return (u + 0x7fffu + ((u >> 16) & 1u)) >> 16; }
__device__ __forceinline__ unsigned pk2(float lo, float hi) { return f2bf(lo) | (f2bf(hi) << 16); }
__device__ __forceinline__ float wave_sum(float v) {
#pragma unroll
    for (int o = 1; o < 64; o <<= 1) v += __shfl_xor(v, o);
    return v;
}
__device__ __forceinline__ void transpose_item(const float* __restrict__ W, int K, int N, bf16_t* __restrict__ WT, int row_off, LAS float* scr, int item, int lane) {
    const int nblk = N / 64, kb = item / nblk, nb = item % nblk, k0 = 64 * kb, n0 = 64 * nb;
    const float* wp = W + (size_t)k0 * N + n0 + lane;
#pragma unroll
    for (int h = 0; h < 2; ++h) {
        float rr[32];
#pragma unroll
        for (int i = 0; i < 32; ++i) rr[i] = wp[(size_t)(32 * h + i) * N];
#pragma unroll
        for (int i = 0; i < 32; ++i) scr[(32 * h + i) * 65 + lane] = rr[i];
    }
    asm volatile("s_waitcnt lgkmcnt(0)" ::: "memory");
    const int c = lane & 7;
#pragma unroll
    for (int j = 0; j < 8; ++j) { const int n = (lane >> 3) + 8 * j; const LAS float* s = scr + (8 * c) * 65 + n;
        u32x4 o; o.x = pk2(s[0 * 65], s[1 * 65]); o.y = pk2(s[2 * 65], s[3 * 65]); o.z = pk2(s[4 * 65], s[5 * 65]); o.w = pk2(s[6 * 65], s[7 * 65]);
        *(u32x4*)(WT + (size_t)(row_off + n0 + n) * K + k0 + 8 * c) = o; }
    asm volatile("s_waitcnt lgkmcnt(0)" ::: "memory");
}

struct Args { const float* in[22]; float* out; unsigned char* ws; };
enum { I_X = 0, I_NMIX, I_WIN, I_ARE, I_AIM, I_LOGDT, I_BRE, I_BIM, I_CRE, I_CIM, I_DSKIP, I_WGLU, I_BGLU, I_WUPS, I_WUPA, I_WGATE, I_BGATE, I_WOUT, I_NMLP, I_W1, I_W2, I_NFIN };

__device__ __forceinline__ void fast_cis(float th, float& c, float& s) { float r = th * 0.15915494309189535f; r -= rintf(r); c = __builtin_amdgcn_cosf(r); s = __builtin_amdgcn_sinf(r); }
__device__ __forceinline__ void ssm_precompute_item(LAS unsigned char* lds, const Args& a, int item) {
    const int g = item >> 3, part = item & 7, tid = threadIdx.x;
    LAS float* E = (LAS float*)lds;
    LAS float* BB = E + 33 * 64 * 2;
    LAS float* CC = BB + 64 * 16 * 2;
    LAS float* KT = CC + 16 * 64 * 2;
    const float* A_re = a.in[I_ARE] + g * 64; const float* A_im = a.in[I_AIM] + g * 64;
    const float dt = __expf(a.in[I_LOGDT][g]);
    {   const int p = tid & 63; const float ar = A_re[p] * dt, ai = A_im[p] * dt;
        for (int n = tid >> 6; n < 33; n += 8) { const float mag = __expf(ar * (float)n); float c, s; fast_cis(ai * (float)n, c, s); E[(n * 64 + p) * 2] = mag * c; E[(n * 64 + p) * 2 + 1] = mag * s; } }
    for (int idx = tid; idx < 64 * 16; idx += 512) { const int p = idx >> 4, ci = idx & 15; const float lr = A_re[p], li = A_im[p], ar = lr * dt, ai = li * dt;
        float c, s; fast_cis(ai, c, s);
        const float mag = __expf(ar), are = mag * c - 1.0f, aim = mag * s, den = 1.0f / (lr * lr + li * li);
        const float cfr = (are * lr + aim * li) * den, cfi = (aim * lr - are * li) * den;
        const float br = a.in[I_BRE][(size_t)(g * 64 + p) * 16 + ci], bi = a.in[I_BIM][(size_t)(g * 64 + p) * 16 + ci];
        BB[idx * 2] = cfr * br - cfi * bi; BB[idx * 2 + 1] = cfr * bi + cfi * br; }
    for (int idx = tid; idx < 16 * 64; idx += 512) { CC[idx * 2] = a.in[I_CRE][(size_t)g * 1024 + idx]; CC[idx * 2 + 1] = a.in[I_CIM][(size_t)g * 1024 + idx]; }
    __syncthreads();
    {
        const int tl = tid >> 7, co = (tid >> 3) & 15, ci0 = (tid & 7) * 2, tau = 4 * part + tl;
        float acc0 = 0.f, acc1 = 0.f;
        for (int p = 0; p < 64; ++p) {
            const float cr = CC[(co * 64 + p) * 2], ci_ = CC[(co * 64 + p) * 2 + 1], er = E[(tau * 64 + p) * 2], ei = E[(tau * 64 + p) * 2 + 1];
            const float wr = cr * er - ci_ * ei, wi = cr * ei + ci_ * er;
            acc0 += wr * BB[(p * 16 + ci0) * 2] - wi * BB[(p * 16 + ci0) * 2 + 1];
            acc1 += wr * BB[(p * 16 + ci0 + 1) * 2] - wi * BB[(p * 16 + ci0 + 1) * 2 + 1];
        }
        if (tau == 0) { if (ci0 == co) acc0 += a.in[I_DSKIP][g * 16 + co]; if (ci0 + 1 == co) acc1 += a.in[I_DSKIP][g * 16 + co]; }
        KT[(tl * 16 + co) * 16 + ci0] = acc0; KT[(tl * 16 + co) * 16 + ci0 + 1] = acc1;
    }
    __syncthreads();
    bf16_t* TG = (bf16_t*)(a.ws + WS_TG); bf16_t* HH = (bf16_t*)(a.ws + WS_HH);
    for (int idx = tid; idx < 4 * 16 * 32 * 2; idx += 512) {
        const int half = idx & 1, t = (idx >> 1) & 31, co = (idx >> 6) & 15, tl = idx >> 10, tau = 4 * part + tl;
        if (t >= tau) {
            const LAS float* k = KT + (tl * 16 + co) * 16 + 8 * half;
            u32x4 o; o.x = pk2(k[0], k[1]); o.y = pk2(k[2], k[3]); o.z = pk2(k[4], k[5]); o.w = pk2(k[6], k[7]);
            *(u32x4*)(TG + ((size_t)(g * 512 + t * 16 + co)) * KX + (t - tau) * 16 + 8 * half) = o;
        }
    }
    for (int idx = tid; idx < 64 * 80; idx += 512) {
        const int rl = idx / 80, ch = idx - rl * 80, n = part * 64 + rl, t = n >> 4, co = n & 15;
        if (ch < 64) {
            if ((ch >> 1) > t) *(u32x4*)(TG + ((size_t)(g * 512 + n)) * KX + ch * 8) = (u32x4){0u, 0u, 0u, 0u};
        } else {
            float v[8];
#pragma unroll
            for (int e = 0; e < 8; ++e) { const int j = (ch - 64) * 8 + e, p = j & 63; const float cr = CC[(co * 64 + p) * 2], ci_ = CC[(co * 64 + p) * 2 + 1], er = E[((t + 1) * 64 + p) * 2], ei = E[((t + 1) * 64 + p) * 2 + 1];
                v[e] = (j < 64) ? (cr * er - ci_ * ei) : -(cr * ei + ci_ * er); }
            u32x4 o; o.x = pk2(v[0], v[1]); o.y = pk2(v[2], v[3]); o.z = pk2(v[4], v[5]); o.w = pk2(v[6], v[7]);
            *(u32x4*)(TG + ((size_t)(g * 512 + n)) * KX + ch * 8) = o;
        }
    }
    for (int idx = tid; idx < 32 * 64; idx += 512) {
        const int rl = idx >> 6, ch = idx & 63, jr = part * 32 + rl, s = ch >> 1, ci0 = (ch & 1) * 8;
        float v[8];
#pragma unroll
        for (int e = 0; e < 8; ++e) { float x = 0.f;
            if (jr < 128) { const int p = jr & 63; const float er = E[((31 - s) * 64 + p) * 2], ei = E[((31 - s) * 64 + p) * 2 + 1], br = BB[(p * 16 + ci0 + e) * 2], bi = BB[(p * 16 + ci0 + e) * 2 + 1];
                x = (jr < 64) ? (er * br - ei * bi) : (er * bi + ei * br); }
            v[e] = x; }
        u32x4 o; o.x = pk2(v[0], v[1]); o.y = pk2(v[2], v[3]); o.z = pk2(v[4], v[5]); o.w = pk2(v[6], v[7]);
        *(u32x4*)(HH + ((size_t)(g * 256 + jr)) * 512 + ch * 8) = o;
    }
    if (part == 0 && tid < 64) { float* AP = (float*)(a.ws + WS_APOW); AP[(g * 64 + tid) * 2] = E[(32 * 64 + tid) * 2]; AP[(g * 64 + tid) * 2 + 1] = E[(32 * 64 + tid) * 2 + 1]; }
    __syncthreads();
}

__device__ __forceinline__ void prologue(LAS unsigned char* lds, const Args& a) {
    const int tid = threadIdx.x, lane = tid & 63, wave = tid >> 6, G = gridDim.x;
    { float* rs = (float*)(a.ws + WS_CTL); for (int i = blockIdx.x * 512 + tid; i < 2 * M; i += G * 512) rs[i] = 0.f; }
    for (int it = blockIdx.x; it < 256; it += G) ssm_precompute_item(lds, a, it);
    LAS float* scr = (LAS float*)(lds + wave * 16640);
    const int gw = blockIdx.x * 8 + wave, NGW = G * 8;
    bf16_t* WCAT = (bf16_t*)(a.ws + WS_WCAT);
    constexpr int I_IN = 16 * 32, I_GT = 16 * 32, I_GLU = 8 * 8, I_UPS = 8 * 16, I_UPA = 8 * 16, I_OUT = 16 * 16, I_F1 = 16 * 64, I_F2 = 64 * 16;
    constexpr int NITEMS = I_IN + I_GT + I_GLU + I_UPS + I_UPA + I_OUT + I_F1 + I_F2;
    for (int it = gw; it < NITEMS; it += NGW) {
        int r = it;
        if (r < I_IN) { transpose_item(a.in[I_WIN], 1024, 2048, WCAT, 0, scr, r, lane); continue; } r -= I_IN;
        if (r < I_GT) { transpose_item(a.in[I_WGATE], 1024, 2048, WCAT, 2048, scr, r, lane); continue; } r -= I_GT;
        if (r < I_GLU) { transpose_item(a.in[I_WGLU], 512, 512, (bf16_t*)(a.ws + WS_WGLU), 0, scr, r, lane); continue; } r -= I_GLU;
        if (r < I_UPS) { transpose_item(a.in[I_WUPS], 512, 1024, (bf16_t*)(a.ws + WS_WUPS), 0, scr, r, lane); continue; } r -= I_UPS;
        if (r < I_UPA) { transpose_item(a.in[I_WUPA], 512, 1024, (bf16_t*)(a.ws + WS_WUPA), 0, scr, r, lane); continue; } r -= I_UPA;
        if (r < I_OUT) { transpose_item(a.in[I_WOUT], 1024, 1024, (bf16_t*)(a.ws + WS_WOUT), 0, scr, r, lane); continue; } r -= I_OUT;
        if (r < I_F1) { transpose_item(a.in[I_W1], 1024, 4096, (bf16_t*)(a.ws + WS_W1), 0, scr, r, lane); continue; } r -= I_F1;
        transpose_item(a.in[I_W2], 4096, 1024, (bf16_t*)(a.ws + WS_W2), 0, scr, r, lane);
    }
    const float* x = a.in[I_X]; const float* gm = a.in[I_NMIX]; bf16_t* XN = (bf16_t*)(a.ws + WS_XN);
    f32x4 gv[4];
#pragma unroll
    for (int j = 0; j < 4; ++j) gv[j] = *((const f32x4*)gm + 64 * j + lane);
    for (int m0 = gw * 4; m0 < M; m0 += NGW * 4) {
        f32x4 v[4][4]; float s[4];
#pragma unroll
        for (int r = 0; r < 4; ++r) { const f32x4* xr = (const f32x4*)(x + (size_t)(m0 + r) * DM) + lane;
#pragma unroll
            for (int j = 0; j < 4; ++j) v[r][j] = xr[64 * j]; }
#pragma unroll
        for (int r = 0; r < 4; ++r) { float t = 0.f;
#pragma unroll
            for (int j = 0; j < 4; ++j) t += (v[r][j][0] * v[r][j][0] + v[r][j][1] * v[r][j][1]) + (v[r][j][2] * v[r][j][2] + v[r][j][3] * v[r][j][3]);
            s[r] = t; }
#pragma unroll
        for (int o = 1; o < 64; o <<= 1) {
#pragma unroll
            for (int r = 0; r < 4; ++r) s[r] += __shfl_xor(s[r], o); }
#pragma unroll
        for (int r = 0; r < 4; ++r) { const float rstd = 1.0f / sqrtf(s[r] * (1.0f / DM) + EPSN);
            u32x2* o8 = (u32x2*)(XN + (size_t)(m0 + r) * DM) + lane;
#pragma unroll
            for (int j = 0; j < 4; ++j) { u32x2 o; o.x = pk2(v[r][j][0] * rstd * gv[j][0], v[r][j][1] * rstd * gv[j][1]); o.y = pk2(v[r][j][2] * rstd * gv[j][2], v[r][j][3] * rstd * gv[j][3]); o8[64 * j] = o; } }
    }
}

__device__ __forceinline__ void scan_phase(LAS unsigned char* lds, const Args& a) {
    int tid_ = threadIdx.x; asm volatile("" : "+v"(tid_));
    const int tid = tid_, lane = tid & 63, w = __builtin_amdgcn_readfirstlane(tid >> 6);
    const float* S = (const float*)(a.ws + WS_S); const float* AP = (const float*)(a.ws + WS_APOW); bf16_t* USX = (bf16_t*)(a.ws + WS_USX);
    LAS float* seg = (LAS float*)lds;
    for (int it = blockIdx.x; it < 256; it += gridDim.x) {
        const int g = it >> 3, b = it & 3, p = lane;
        const float alr = AP[(g * 64 + p) * 2], ali = AP[(g * 64 + p) * 2 + 1];
        const size_t row0 = (size_t)g * 1024 + b * 256 + 32 * w;
        float sr[32], si[32];
#pragma unroll
        for (int i = 0; i < 32; ++i) { sr[i] = S[(row0 + i) * 128 + p]; si[i] = S[(row0 + i) * 128 + 64 + p]; }
        float xr = 0.f, xi = 0.f;
#pragma unroll
        for (int i = 0; i < 32; ++i) { const float tr = xr, ti = xi; const float nr = alr * xr - ali * xi + sr[i], ni = alr * xi + ali * xr + si[i]; xr = nr; xi = ni; sr[i] = tr; si[i] = ti; }
        seg[(w * 64 + p) * 2] = xr; seg[(w * 64 + p) * 2 + 1] = xi;
        float a32r = alr, a32i = ali;
#pragma unroll
        for (int k = 0; k < 5; ++k) { const float tr = a32r * a32r - a32i * a32i, ti = 2.f * a32r * a32i; a32r = tr; a32i = ti; }
        __syncthreads();
        float x0r = 0.f, x0i = 0.f;
        for (int ww = 0; ww < w; ++ww) { const float er = seg[(ww * 64 + p) * 2], ei = seg[(ww * 64 + p) * 2 + 1]; const float nr = a32r * x0r - a32i * x0i + er, ni = a32r * x0i + a32i * x0r + ei; x0r = nr; x0i = ni; }
        float pr = 1.f, pi = 0.f;
#pragma unroll
        for (int i = 0; i < 32; ++i) {
            const float vr = sr[i] + pr * x0r - pi * x0i, vi = si[i] + pr * x0i + pi * x0r;
            bf16_t* d = USX + (row0 + i) * KX + 512 + p; d[0] = (bf16_t)f2bf(vr); d[64] = (bf16_t)f2bf(vi);
            const float tr = pr * alr - pi * ali, ti = pr * ali + pi * alr; pr = tr; pi = ti;
        }
        asm volatile("s_waitcnt vmcnt(0)" ::: "memory");
        __syncthreads();
    }
}

__device__ __forceinline__ void attn_phase(LAS unsigned char* lds, const Args& a) {
    int tid_ = threadIdx.x; asm volatile("" : "+v"(tid_));
    const int tid = tid_, lane = tid & 63, w = __builtin_amdgcn_readfirstlane(tid >> 6), l31 = lane & 31, hi = lane >> 5;
    const bf16_t* __restrict__ QKV = (const bf16_t*)(a.ws + WS_QKV); bf16_t* __restrict__ YATT = (bf16_t*)(a.ws + WS_YATT);
    constexpr float LOG2E = 1.4426950408889634f, LN2 = 0.6931471805599453f, NEG_INF = -__builtin_inff();
    const int skey = tid >> 3, sch = tid & 7;
    const unsigned kst = skey * 128 + ((sch ^ ((skey >> 1) & 7)) << 4), vst = 8192 + skey * 128 + ((sch ^ (((skey >> 1) & 1) << 2)) << 4);
    unsigned koff[4];
#pragma unroll
    for (int s = 0; s < 4; ++s) koff[s] = l31 * 128 + (((2 * s + hi) ^ ((l31 >> 1) & 7)) << 4);
    const int tq = (lane & 15) >> 2, tc2 = 2 * ((lane >> 4) & 1) + ((lane & 3) >> 1), tb = (tq >> 1) & 1;
    const unsigned vbase = 8192 + (4 * hi + tq) * 128 + tc2 * 16 + (lane & 1) * 8;
    for (int ui = 0;; ++ui) {
        int L; { const int G = gridDim.x, c = blockIdx.x;
            if (G == 256) L = (c < 128) ? (ui < 3 ? c + 256 * ui : -1) : (ui < 4 ? c + 256 * ui : (ui == 4 ? 768 + (c - 128) : -1));
            else { L = c + ui * G; if (L >= 1024) L = -1; } }
        if (L < 0) break;
        const int bh = L & 31, qb = 31 - (L >> 5), b = bh >> 3, h = bh & 7, q0 = qb * 256;
        const size_t rowbase = (size_t)b * SEQ;
        const int qmin = q0 + 32 * w, qpos = qmin + l31;
        bf16x8 qf[4];
        { const bf16_t* qp = QKV + (rowbase + qpos) * 1536 + h * 64 + 8 * hi;
#pragma unroll
          for (int s = 0; s < 4; ++s) qf[s] = *(const bf16x8*)(qp + 16 * s); }
        f32x16 o0, o1;
#pragma unroll
        for (int r = 0; r < 16; ++r) { o0[r] = 0.f; o1[r] = 0.f; }
        float R = 0.f; bool wdone = false;
        const int jmax = qb * 4 + 3;
        const bf16_t* kvp = QKV + (rowbase + skey) * 1536 + 512 + h * 64 + sch * 8;
        u32x4 kreg = *(const u32x4*)(kvp + (size_t)jmax * 64 * 1536), vreg = *(const u32x4*)(kvp + (size_t)jmax * 64 * 1536 + 512);
        *(LAS u32x4*)(lds + kst) = kreg; *(LAS u32x4*)(lds + vst) = vreg;
        __syncthreads();
        int buf = 0;
        for (int j = jmax; j >= 0; --j) {
            if (j > 0) { kreg = *(const u32x4*)(kvp + (size_t)(j - 1) * 64 * 1536); vreg = *(const u32x4*)(kvp + (size_t)(j - 1) * 64 * 1536 + 512); }
            const int kbase = 64 * j;
            if (kbase < qmin + 31 && !wdone) {
                const LAS unsigned char* kb = lds + buf * 16384;
                f32x16 p0, p1;
#pragma unroll
                for (int r = 0; r < 16; ++r) { p0[r] = 0.f; p1[r] = 0.f; }
#pragma unroll
                for (int s = 0; s < 4; ++s) {
                    const bf16x8 k0 = *(const LAS bf16x8*)(kb + koff[s]), k1 = *(const LAS bf16x8*)(kb + koff[s] + 4096);
                    p0 = __builtin_amdgcn_mfma_f32_32x32x16_bf16(k0, qf[s], p0, 0, 0, 0);
                    p1 = __builtin_amdgcn_mfma_f32_32x32x16_bf16(k1, qf[s], p1, 0, 0, 0);
                }
                const bool need_mask = (kbase + 63 >= qmin);
                float lf0[16], lf1[16];
#pragma unroll
                for (int r = 0; r < 16; ++r) {
                    const int key0 = kbase + (r & 3) + 8 * (r >> 2) + 4 * hi;
                    { const float z = p0[r] * 0.125f; const float e = __builtin_amdgcn_exp2f(-fabsf(z) * LOG2E); const float sp = fmaxf(z, 0.f) + __builtin_amdgcn_logf(1.0f + e) * LN2;
                      float lfv = -sp, lsg = z - sp; if (need_mask && key0 >= qpos) { lfv = 0.f; lsg = NEG_INF; } lf0[r] = lfv; p0[r] = lsg; }
                    { const float z = p1[r] * 0.125f; const float e = __builtin_amdgcn_exp2f(-fabsf(z) * LOG2E); const float sp = fmaxf(z, 0.f) + __builtin_amdgcn_logf(1.0f + e) * LN2;
                      float lfv = -sp, lsg = z - sp; if (need_mask && key0 + 32 >= qpos) { lfv = 0.f; lsg = NEG_INF; } lf1[r] = lfv; p1[r] = lsg; }
                }
                float qs[8], ps[8];
#pragma unroll
                for (int g4 = 0; g4 < 4; ++g4) { qs[g4] = (lf0[4 * g4] + lf0[4 * g4 + 1]) + (lf0[4 * g4 + 2] + lf0[4 * g4 + 3]); qs[4 + g4] = (lf1[4 * g4] + lf1[4 * g4 + 1]) + (lf1[4 * g4 + 2] + lf1[4 * g4 + 3]); }
#pragma unroll
                for (int k = 0; k < 8; ++k) ps[k] = __shfl_xor(qs[k], 32);
                float run = 0.f;
#pragma unroll
                for (int k = 7; k >= 0; --k) {
                    const float base = R + run + (hi == 0 ? ps[k] : 0.f);
                    run += qs[k] + ps[k];
                    const int g4 = k & 3;
                    if (k < 4) {
                        const float a3 = base, a2 = a3 + lf0[4 * g4 + 3], a1 = a2 + lf0[4 * g4 + 2], a0 = a1 + lf0[4 * g4 + 1];
                        p0[4 * g4 + 3] = __builtin_amdgcn_exp2f((p0[4 * g4 + 3] + a3) * LOG2E); p0[4 * g4 + 2] = __builtin_amdgcn_exp2f((p0[4 * g4 + 2] + a2) * LOG2E);
                        p0[4 * g4 + 1] = __builtin_amdgcn_exp2f((p0[4 * g4 + 1] + a1) * LOG2E); p0[4 * g4 + 0] = __builtin_amdgcn_exp2f((p0[4 * g4 + 0] + a0) * LOG2E);
                    } else {
                        const float a3 = base, a2 = a3 + lf1[4 * g4 + 3], a1 = a2 + lf1[4 * g4 + 2], a0 = a1 + lf1[4 * g4 + 1];
                        p1[4 * g4 + 3] = __builtin_amdgcn_exp2f((p1[4 * g4 + 3] + a3) * LOG2E); p1[4 * g4 + 2] = __builtin_amdgcn_exp2f((p1[4 * g4 + 2] + a2) * LOG2E);
                        p1[4 * g4 + 1] = __builtin_amdgcn_exp2f((p1[4 * g4 + 1] + a1) * LOG2E); p1[4 * g4 + 0] = __builtin_amdgcn_exp2f((p1[4 * g4 + 0] + a0) * LOG2E);
                    }
                }
                R += run;
                bf16x8 pb[4];
#pragma unroll
                for (int s = 0; s < 2; ++s) {
                    u32x4 w0, w1;
                    w0.x = pg8::cvt_pk_bf16(p0[8 * s + 0], p0[8 * s + 1]); w0.y = pg8::cvt_pk_bf16(p0[8 * s + 2], p0[8 * s + 3]); w0.z = pg8::cvt_pk_bf16(p0[8 * s + 4], p0[8 * s + 5]); w0.w = pg8::cvt_pk_bf16(p0[8 * s + 6], p0[8 * s + 7]);
                    w1.x = pg8::cvt_pk_bf16(p1[8 * s + 0], p1[8 * s + 1]); w1.y = pg8::cvt_pk_bf16(p1[8 * s + 2], p1[8 * s + 3]); w1.z = pg8::cvt_pk_bf16(p1[8 * s + 4], p1[8 * s + 5]); w1.w = pg8::cvt_pk_bf16(p1[8 * s + 6], p1[8 * s + 7]);
                    pb[s] = __builtin_bit_cast(bf16x8, w0); pb[2 + s] = __builtin_bit_cast(bf16x8, w1);
                }
#pragma unroll
                for (int dblk = 0; dblk < 2; ++dblk)
#pragma unroll
                    for (int ss = 0; ss < 4; ++ss) {
                        const unsigned ad = vbase + ss * 2048 + ((dblk ^ tb) << 6);
                        const v4i16_t lo = __builtin_amdgcn_ds_read_tr16_b64_v4i16((LAS v4i16_t*)(kb + ad));
                        const v4i16_t hi4 = __builtin_amdgcn_ds_read_tr16_b64_v4i16((LAS v4i16_t*)(kb + ad + 1024));
                        bf16x8 vf; vf[0] = lo[0]; vf[1] = lo[1]; vf[2] = lo[2]; vf[3] = lo[3]; vf[4] = hi4[0]; vf[5] = hi4[1]; vf[6] = hi4[2]; vf[7] = hi4[3];
                        if (dblk == 0) o0 = __builtin_amdgcn_mfma_f32_32x32x16_bf16(vf, pb[ss], o0, 0, 0, 0);
                        else o1 = __builtin_amdgcn_mfma_f32_32x32x16_bf16(vf, pb[ss], o1, 0, 0, 0);
                    }
                wdone = __all(R < -100.0f);
            }
            if (j > 0) { *(LAS u32x4*)(lds + (buf ^ 1) * 16384 + kst) = kreg; *(LAS u32x4*)(lds + (buf ^ 1) * 16384 + vst) = vreg; }
            const int alld = __syncthreads_and(wdone ? 1 : 0);
            buf ^= 1;
            if (alld) break;
        }
        bf16_t* op = YATT + (rowbase + qpos) * 512 + h * 64 + 4 * hi;
#pragma unroll
        for (int g4 = 0; g4 < 4; ++g4) {
            u32x2 w0, w1;
            w0.x = pg8::cvt_pk_bf16(o0[4 * g4], o0[4 * g4 + 1]); w0.y = pg8::cvt_pk_bf16(o0[4 * g4 + 2], o0[4 * g4 + 3]);
            w1.x = pg8::cvt_pk_bf16(o1[4 * g4], o1[4 * g4 + 1]); w1.y = pg8::cvt_pk_bf16(o1[4 * g4 + 2], o1[4 * g4 + 3]);
            *(u32x2*)(op + 8 * g4) = w0; *(u32x2*)(op + 32 + 8 * g4) = w1;
        }
    }
}

__device__ __forceinline__ void final_phase(const Args& a) {
    const int tid = threadIdx.x, lane = tid & 63, wave = tid >> 6;
    const int gw = blockIdx.x * 8 + wave, NGW = gridDim.x * 8;
    const float* rs2 = (const float*)(a.ws + WS_CTL) + M; const float* gf = a.in[I_NFIN];
    f32x4 gv[4];
#pragma unroll
    for (int j = 0; j < 4; ++j) gv[j] = *((const f32x4*)gf + 64 * j + lane);
    for (int m = gw; m < M; m += NGW) {
        f32x4* xr = (f32x4*)(a.out + (size_t)m * DM) + lane;
        const float rstd = 1.0f / sqrtf(rs2[m] * (1.0f / DM) + EPSN);
#pragma unroll
        for (int j = 0; j < 4; ++j) { f32x4 v = xr[64 * j]; v = v * rstd * gv[j]; xr[64 * j] = v; }
    }
}

#define XB_TMO      128
#define XB_XCNT(j)  (256  + 64 * (j))
#define XB_XSUB(j)  (1280 + 64 * (j))
#define XB_XGEN(j)  (2304 + 64 * (j))
#define XB_TOP      3328
#define XB_TOPGEN   3392
#define XCD_BAR_WORDS 3456
#define XB_SPIN_CAP (1u << 18)

__device__ __forceinline__ unsigned xb_ld(unsigned* p)              { return __hip_atomic_load(p, __ATOMIC_RELAXED, __HIP_MEMORY_SCOPE_AGENT); }
__device__ __forceinline__ unsigned xb_add(unsigned* p, unsigned v) { return __hip_atomic_fetch_add(p, v, __ATOMIC_RELAXED, __HIP_MEMORY_SCOPE_AGENT); }
__device__ __forceinline__ unsigned xb_xcc_id() { return (unsigned)__builtin_amdgcn_s_getreg((3 << 11) | 20) & 0xFu; }
#define XB_SPIN(cond, bar) do { unsigned _sp = 0; while (cond) { __builtin_amdgcn_s_sleep(1); \
    if ((++_sp & 255u) == 0u) { if (xb_ld(&(bar)[XB_TMO])) break; if (_sp > XB_SPIN_CAP) { atomicAdd(&(bar)[XB_TMO], 1u); break; } } } } while (0)

struct XcdBarrier {
    unsigned* bar; unsigned x;
    volatile LAS unsigned* st;
};

__device__ __forceinline__ XcdBarrier xcd_barrier_post(unsigned* bar, volatile LAS unsigned* st) {
    XcdBarrier b; b.bar = bar; b.x = xb_xcc_id(); b.st = st;
    if (threadIdx.x == 0) (void)xb_add(&bar[XB_XCNT(b.x)], 1u);
    return b;
}
__device__ __forceinline__ void xcd_barrier_complete(unsigned* bar, unsigned x, unsigned& nloc, unsigned& nx) {
    const unsigned G = gridDim.x * gridDim.y * gridDim.z;
    unsigned sum, cnt, mine, sp = 0u;
    for (;;) {
        sum = 0u; cnt = 0u; mine = 0u;
#pragma unroll
        for (unsigned j = 0; j < 16; ++j) { const unsigned c = xb_ld(&bar[XB_XCNT(j)]); sum += c; cnt += (c > 0u) ? 1u : 0u; mine = (j == x) ? c : mine; }
        if (sum == G) break;
        __builtin_amdgcn_s_sleep(1);
        if ((++sp & 255u) == 0u) { if (xb_ld(&bar[XB_TMO])) break; if (sp > XB_SPIN_CAP) { atomicAdd(&bar[XB_TMO], 1u); break; } }
    }
    nloc = mine > 0u ? mine : 1u; nx = cnt > 0u ? cnt : 1u;
}

__device__ __forceinline__ void xcd_barrier(const XcdBarrier& b) {
    asm volatile("s_waitcnt vmcnt(0)" ::: "memory");
    __syncthreads();
    if (threadIdx.x == 0) {
        unsigned* bar = b.bar;
        __builtin_amdgcn_s_waitcnt(0);
        unsigned nloc = b.st[0], nx = b.st[1];
        if (nloc == 0u) { xcd_barrier_complete(bar, b.x, nloc, nx); b.st[0] = nloc; b.st[1] = nx; }
        const unsigned old = xb_add(&bar[XB_XSUB(b.x)], 1u);
        const unsigned gen = old / nloc;
        if (old + 1u == (gen + 1u) * nloc) {
            __builtin_amdgcn_fence(__ATOMIC_RELEASE, "agent");
            asm volatile("s_waitcnt vmcnt(0)" ::: "memory");
            const unsigned og = xb_add(&bar[XB_TOP], 1u);
            const unsigned tg = og / nx;
            if (og + 1u == (tg + 1u) * nx) xb_add(&bar[XB_TOPGEN], 1u);
            else XB_SPIN(xb_ld(&bar[XB_TOPGEN]) == tg, bar);
            __builtin_amdgcn_fence(__ATOMIC_ACQUIRE, "agent");
            xb_add(&bar[XB_XGEN(b.x)], 1u);
            asm volatile("s_waitcnt vmcnt(0)" ::: "memory");
        } else {
            XB_SPIN(xb_ld(&bar[XB_XGEN(b.x)]) == gen, bar);
            __builtin_amdgcn_fence(__ATOMIC_ACQUIRE, "agent");
            asm volatile("s_waitcnt vmcnt(0)" ::: "memory");
        }
    }
    __syncthreads();
}

constexpr size_t WS_BAR = 512 * 1024;
constexpr int LDS_MISC = LDS_BYTES - 512;
__global__ void __launch_bounds__(512, 2) fwd_megakernel(Args a) {
    extern __shared__ __attribute__((aligned(16))) unsigned char lds_raw[];
    LAS unsigned char* lds = (LAS unsigned char*)lds_raw;
    cg::grid_group grid = cg::this_grid();
    const int G = gridDim.x, c = blockIdx.x;
    unsigned char* ws = a.ws;
    if (ws == nullptr) grid.sync();
    volatile LAS unsigned* bst = (volatile LAS unsigned*)(lds + LDS_MISC);
    if (threadIdx.x < 2) bst[threadIdx.x] = 0u;
    __syncthreads();
    const XcdBarrier xbar = xcd_barrier_post((unsigned*)(ws + WS_BAR), bst);
#ifndef PROF_A
#define PROF_A -1
#define PROF_B 0
#define PROF_K 4
#endif
    volatile LAS unsigned long long* stamps = (volatile LAS unsigned long long*)(lds + LDS_MISC + 64);
    int n_stamp = 0;
#define STAMP() do { if (PROF_A >= 0) { if (threadIdx.x == 0) stamps[n_stamp] = __builtin_amdgcn_s_memrealtime(); ++n_stamp; } } while (0)
    STAMP();
#define GRID_SYNC() do { xcd_barrier(xbar); STAMP(); } while (0)
    bf16_t* USX = (bf16_t*)(ws + WS_USX); bf16_t* QKV = (bf16_t*)(ws + WS_QKV); bf16_t* GATES = (bf16_t*)(ws + WS_GATES);
    bf16_t* Y1 = (bf16_t*)(ws + WS_Y1); bf16_t* Y2 = (bf16_t*)(ws + WS_Y2); bf16_t* YATT = (bf16_t*)(ws + WS_YATT);
    bf16_t* T1 = (bf16_t*)(ws + WS_XN); bf16_t* HN = (bf16_t*)(ws + WS_QKV); bf16_t* HID = (bf16_t*)(ws + WS_HID);
    float* rs1 = (float*)(ws + WS_CTL); float* rs2 = rs1 + M;
    prologue(lds, a);
    GRID_SYNC();
    { pg8::Gemm g{(const bf16_t*)(ws + WS_XN), (const bf16_t*)(ws + WS_WCAT), 1024, 1024}; pg8::StaticOrder S; S.init(M, 4096, G, c);
      pg8::EpiProj E{USX, QKV, GATES, a.in[I_BGATE]};
      pg8::gemm_phase<pg8::EpiProj, pg8::StaticOrder, true, true>(lds, g, S, E); }
    GRID_SYNC();
    { pg8::Gemm g{USX, (const bf16_t*)(ws + WS_HH), KX, 512}; pg8::GroupOrder S{128, G, c, 0};
      pg8::EpiState E{(float*)(ws + WS_S)};
      pg8::gemm_phase<pg8::EpiState, pg8::GroupOrder, true, true>(lds, g, S, E); }
    attn_phase(lds, a);
    GRID_SYNC();
    scan_phase(lds, a);
    { pg8::Gemm g{USX, (const bf16_t*)(ws + WS_TG), KX, KX}; pg8::GroupOrder S{256, G, c, 1};
      pg8::EpiSsmY E{Y1};
      pg8::gemm_phase<pg8::EpiSsmY, pg8::GroupOrder, true, true>(lds, g, S, E); }
    GRID_SYNC();
    { pg8::Gemm g{Y1, (const bf16_t*)(ws + WS_WGLU), 512, 512}; pg8::StaticOrder S; S.init(M, 512, G, c);
      pg8::EpiGlu E{Y1, Y2, a.in[I_BGLU]};
      pg8::gemm_phase<pg8::EpiGlu, pg8::StaticOrder, true, true>(lds, g, S, E); }
    GRID_SYNC();
    { pg8::Gemm g{Y2, (const bf16_t*)(ws + WS_WUPS), 512, 512}; pg8::StaticOrder S; S.init(M, 1024, G, c);
      pg8::EpiUp<false> E{GATES, T1, 0};
      pg8::gemm_phase<pg8::EpiUp<false>, pg8::StaticOrder, true, true>(lds, g, S, E); }
    { pg8::Gemm g{YATT, (const bf16_t*)(ws + WS_WUPA), 512, 512}; pg8::StaticOrder S; S.init(M, 1024, G, c);
      pg8::EpiUp<true> E{GATES, T1, 1024};
      pg8::gemm_phase<pg8::EpiUp<true>, pg8::StaticOrder, true, true>(lds, g, S, E); }
    GRID_SYNC();
    { pg8::Gemm g{T1, (const bf16_t*)(ws + WS_WOUT), 1024, 1024}; pg8::StaticOrder S; S.init(M, 1024, G, c);
      pg8::EpiOut E{a.in[I_X], a.out, HN, a.in[I_NMLP], rs1};
      pg8::gemm_phase<pg8::EpiOut, pg8::StaticOrder, true, true>(lds, g, S, E); }
    GRID_SYNC();
    { pg8::Gemm g{HN, (const bf16_t*)(ws + WS_W1), 1024, 1024}; pg8::StaticOrder S; S.init(M, 4096, G, c);
      pg8::EpiFf1 E{rs1, HID};
      pg8::gemm_phase<pg8::EpiFf1, pg8::StaticOrder, true, true>(lds, g, S, E); }
    GRID_SYNC();
    { pg8::Gemm g{HID, (const bf16_t*)(ws + WS_W2), 4096, 4096}; pg8::StaticOrder S; S.init(M, 1024, G, c);
      pg8::EpiFf2 E{a.out, rs2};
      pg8::gemm_phase<pg8::EpiFf2, pg8::StaticOrder, true, true>(lds, g, S, E); }
    GRID_SYNC();
    final_phase(a);
    if (PROF_A >= 0) {
        STAMP();
        if (threadIdx.x == 0) { const unsigned long long d = (stamps[PROF_B] - stamps[PROF_A]) * PROF_K, t0 = __builtin_amdgcn_s_memrealtime(); while (__builtin_amdgcn_s_memrealtime() - t0 < d) __builtin_amdgcn_s_sleep(8); }
        __syncthreads();
    }
}

extern "C" void kernel_launch(void* const* d_in, const int* in_sizes, int n_in, void* d_out, int out_size, void* d_ws, size_t ws_size, hipStream_t stream) {
    static int grid = 0;
    if (grid == 0) {
        if (n_in != 22 || in_sizes[0] != M * DM || out_size != M * DM || ws_size < WS_END) { fprintf(stderr, "kernel_launch: unexpected shapes (n_in %d, in0 %d, out %d, ws %zu); nothing launched\n", n_in, n_in > 0 ? in_sizes[0] : -1, out_size, ws_size); grid = -1; return; }
        int dev = 0, cus = 0, per_cu = 0;
        (void)hipGetDevice(&dev);
        (void)hipDeviceGetAttribute(&cus, hipDeviceAttributeMultiprocessorCount, dev);
        (void)hipFuncSetAttribute((const void*)fwd_megakernel, hipFuncAttributeMaxDynamicSharedMemorySize, LDS_BYTES);
        (void)hipOccupancyMaxActiveBlocksPerMultiprocessor(&per_cu, (const void*)fwd_megakernel, 512, LDS_BYTES);
        if (per_cu < 1) per_cu = 1;
        grid = cus * per_cu;
        fprintf(stderr, "kernel_launch: grid %d (cus %d x %d)\n", grid, cus, per_cu);
    }
    if (grid < 0) return;
    Args a{};
    for (int i = 0; i < 22; ++i) a.in[i] = (const float*)d_in[i];
    a.out = (float*)d_out; a.ws = (unsigned char*)d_ws;
    void* args[] = {&a};
    (void)hipMemsetAsync((unsigned char*)d_ws + WS_BAR, 0, XCD_BAR_WORDS * 4, stream);
    hipError_t e = hipLaunchCooperativeKernel((const void*)fwd_megakernel, dim3(grid), dim3(512), args, LDS_BYTES, stream);
    if (e != hipSuccess) fprintf(stderr, "cooperative launch failed: %s (grid %d)\n", hipGetErrorString(e), grid);
}
```
